# Optimizing an MI355X kernel written in HIP

```python
import math
import jax, jax.numpy as jnp
from jax import lax
import numpy as np

D_MODEL = 1024
BATCH = 8
SEQ = 4096
DEPTH = 4

EXPAND = 2
MIX_WIDTH = EXPAND * D_MODEL
PLE_DIM = 256
N_A = DEPTH // 2
N_B = DEPTH - N_A
EPS = 1e-6

GLA_HEADS = 4
GLA_KEY_WIDTH = MIX_WIDTH // 2
GLA_DK = GLA_KEY_WIDTH // GLA_HEADS
GLA_DV = MIX_WIDTH // GLA_HEADS
GLA_GATE_RANK = 16
GLA_GATE_NORMALIZER = 16.0
GLA_CHUNK = 64
GLA_IN_COLS = 2 * GLA_KEY_WIDTH + 2 * MIX_WIDTH + GLA_GATE_RANK

DIFF_HEAD_DIM = 128
DIFF_HEADS = MIX_WIDTH // (2 * DIFF_HEAD_DIM)
DIFF_QBLOCK = 128
DIFF_IN_COLS = 2 * MIX_WIDTH
KV_COLS = 2 * MIX_WIDTH

kernel_name = "yoco_gla_diffattn_hybrid"


def _rmsnorm(x, g):
    xf = x.astype(jnp.float32)
    y = xf * lax.rsqrt(jnp.mean(xf * xf, axis=-1, keepdims=True) + EPS)
    return (y * g.astype(jnp.float32)).astype(x.dtype)


def _to_chunks(t):
    b, s, h, d = t.shape
    return t.reshape(b, s // GLA_CHUNK, GLA_CHUNK, h, d).transpose(1, 0, 3, 2, 4)


def _gla_mixer(xn, w_in, w_gk2, b_gk, g_norm, w_out):
    bsz, s, _ = xn.shape
    proj = xn @ w_in
    q, k, v, gate, gk_lr = jnp.split(
        proj, [GLA_KEY_WIDTH, 2 * GLA_KEY_WIDTH, 2 * GLA_KEY_WIDTH + MIX_WIDTH,
               2 * GLA_KEY_WIDTH + 2 * MIX_WIDTH], axis=-1)
    gk = gk_lr @ w_gk2 + b_gk
    log_a = jax.nn.log_sigmoid(gk.astype(jnp.float32)) / GLA_GATE_NORMALIZER
    f32 = jnp.float32
    qc = _to_chunks(q.reshape(bsz, s, GLA_HEADS, GLA_DK).astype(f32) * GLA_DK ** -0.5)
    kc = _to_chunks(k.reshape(bsz, s, GLA_HEADS, GLA_DK).astype(f32))
    vc = _to_chunks(v.reshape(bsz, s, GLA_HEADS, GLA_DV).astype(f32))
    bc = jnp.cumsum(_to_chunks(log_a.reshape(bsz, s, GLA_HEADS, GLA_DK)), axis=3)
    causal = jnp.tril(jnp.ones((GLA_CHUNK, GLA_CHUNK), dtype=bool))

    def step(state, inp):
        qi, ki, vi, bi = inp
        inter = jnp.einsum('bhid,bhde->bhie', qi * jnp.exp(bi), state)
        decay = bi[:, :, :, None, :] - bi[:, :, None, :, :]
        decay = jnp.exp(jnp.where(causal[None, None, :, :, None], decay, -jnp.inf))
        scores = jnp.einsum('bhid,bhijd,bhjd->bhij', qi, decay, ki)
        intra = jnp.einsum('bhij,bhje->bhie', scores, vi)
        b_last = bi[:, :, -1, :]
        k_dec = ki * jnp.exp(b_last[:, :, None, :] - bi)
        new_state = jnp.exp(b_last)[..., None] * state + jnp.einsum('bhjd,bhje->bhde', k_dec, vi)
        return new_state, inter + intra

    s0 = jnp.zeros((bsz, GLA_HEADS, GLA_DK, GLA_DV), f32)
    _, o = lax.scan(step, s0, (qc, kc, vc, bc))
    o = o.transpose(1, 0, 3, 2, 4).reshape(bsz, s, GLA_HEADS, GLA_DV)
    o = _rmsnorm(o, g_norm).reshape(bsz, s, MIX_WIDTH)
    o = (o * jax.nn.silu(gate.astype(f32))).astype(xn.dtype)
    return o @ w_out


def _shared_kv(h, kv_norm, w_kv):
    bsz, s, _ = h.shape
    kv = _rmsnorm(h, kv_norm) @ w_kv
    k, v = jnp.split(kv, [MIX_WIDTH], axis=-1)
    k = k.reshape(bsz, s, DIFF_HEADS, 2, DIFF_HEAD_DIM).transpose(0, 2, 3, 1, 4)
    v = v.reshape(bsz, s, DIFF_HEADS, 2 * DIFF_HEAD_DIM).transpose(0, 2, 1, 3)
    return k[:, :, 0], k[:, :, 1], v


def _diff_mixer(xn, k1, k2, v, w_in, lam, g_norm, w_out, lambda_init):
    bsz, s, _ = xn.shape
    q, gate = jnp.split(xn @ w_in, [MIX_WIDTH], axis=-1)
    q = q.reshape(bsz, s, DIFF_HEADS, 2, DIFF_HEAD_DIM)
    nb = s // DIFF_QBLOCK

    def blocks(t):
        return t.reshape(bsz, nb, DIFF_QBLOCK, DIFF_HEADS, DIFF_HEAD_DIM).transpose(1, 0, 3, 2, 4)

    q1b, q2b = blocks(q[..., 0, :]), blocks(q[..., 1, :])
    lamf = lam.astype(jnp.float32)
    lam_full = (jnp.exp(jnp.sum(lamf[0] * lamf[1])) - jnp.exp(jnp.sum(lamf[2] * lamf[3]))
                + lambda_init)
    scale = DIFF_HEAD_DIM ** -0.5
    kpos = jnp.arange(s, dtype=jnp.int32)
    starts = jnp.arange(nb, dtype=jnp.int32) * DIFF_QBLOCK

    def block(args):
        qb1, qb2, start = args
        mask = kpos[None, :] <= (start + jnp.arange(DIFF_QBLOCK, dtype=jnp.int32))[:, None]
        s1 = jnp.einsum('bhqd,bhkd->bhqk', qb1, k1).astype(jnp.float32) * scale
        s2 = jnp.einsum('bhqd,bhkd->bhqk', qb2, k2).astype(jnp.float32) * scale
        p1 = jax.nn.softmax(jnp.where(mask, s1, -jnp.inf), axis=-1)
        p2 = jax.nn.softmax(jnp.where(mask, s2, -jnp.inf), axis=-1)
        attn = (p1 - lam_full * p2).astype(v.dtype)
        return jnp.einsum('bhqk,bhkd->bhqd', attn, v)

    o = lax.map(block, (q1b, q2b, starts))
    o = o.transpose(1, 0, 3, 2, 4).reshape(bsz, s, DIFF_HEADS, 2 * DIFF_HEAD_DIM)
    o = _rmsnorm(o, g_norm) * (1.0 - lambda_init)
    o = o.reshape(bsz, s, MIX_WIDTH)
    o = (o.astype(jnp.float32) * jax.nn.silu(gate.astype(jnp.float32))).astype(xn.dtype)
    return o @ w_out


def _ple(h, p_i, g_norm, w_gate, w_proj):
    gate = jax.nn.sigmoid((_rmsnorm(h, g_norm) @ w_gate).astype(jnp.float32))
    return (gate * (p_i @ w_proj).astype(jnp.float32)).astype(h.dtype)


def setup_inputs(seed: int = 0) -> dict:
    key = jax.random.key(seed)
    ks = jax.random.split(key, 20)
    f32 = jnp.float32

    def nrm(k, shape, scale):
        return jax.random.normal(k, shape, f32) * scale

    def gain(k, shape):
        return 1.0 + 0.05 * jax.random.normal(k, shape, f32)

    return {
        "x": nrm(ks[0], (BATCH, SEQ, D_MODEL), 1.0),
        "p": nrm(ks[1], (DEPTH, BATCH, SEQ, PLE_DIM), 1.0),
        "norm_mix": gain(ks[2], (DEPTH, D_MODEL)),
        "gla_w_in": nrm(ks[3], (N_A, D_MODEL, GLA_IN_COLS), D_MODEL ** -0.5),
        "gla_w_gk2": nrm(ks[4], (N_A, GLA_GATE_RANK, GLA_KEY_WIDTH), GLA_GATE_RANK ** -0.5),
        "gla_b_gk": nrm(ks[5], (N_A, GLA_KEY_WIDTH), 0.1),
        "gla_norm": gain(ks[6], (N_A, GLA_DV)),
        "gla_w_out": nrm(ks[7], (N_A, MIX_WIDTH, D_MODEL), MIX_WIDTH ** -0.5),
        "kv_norm": gain(ks[8], (D_MODEL,)),
        "w_kv": nrm(ks[9], (D_MODEL, KV_COLS), D_MODEL ** -0.5),
        "diff_w_in": nrm(ks[10], (N_B, D_MODEL, DIFF_IN_COLS), D_MODEL ** -0.5),
        "diff_lambda": nrm(ks[11], (N_B, 4, DIFF_HEAD_DIM), 0.1),
        "diff_norm": gain(ks[12], (N_B, 2 * DIFF_HEAD_DIM)),
        "diff_w_out": nrm(ks[13], (N_B, MIX_WIDTH, D_MODEL), MIX_WIDTH ** -0.5),
        "ple_norm": gain(ks[14], (DEPTH, D_MODEL)),
        "ple_w_gate": nrm(ks[15], (DEPTH, D_MODEL, D_MODEL), D_MODEL ** -0.5),
        "ple_w_proj": nrm(ks[16], (DEPTH, PLE_DIM, D_MODEL), PLE_DIM ** -0.5),
        "final_norm": gain(ks[17], (D_MODEL,)),
    }


def reference(x, p, norm_mix, gla_w_in, gla_w_gk2, gla_b_gk, gla_norm, gla_w_out,
              kv_norm, w_kv, diff_w_in, diff_lambda, diff_norm, diff_w_out,
              ple_norm, ple_w_gate, ple_w_proj, final_norm):
    h = x
    k1 = k2 = v = None
    for i in range(DEPTH):
        hn = _rmsnorm(h, norm_mix[i])
        if i < N_A:
            h = h + _gla_mixer(hn, gla_w_in[i], gla_w_gk2[i], gla_b_gk[i], gla_norm[i], gla_w_out[i])
        else:
            j = i - N_A
            lambda_init = 0.8 - 0.6 * math.exp(-0.3 * i)
            h = h + _diff_mixer(hn, k1, k2, v, diff_w_in[j], diff_lambda[j], diff_norm[j],
                                diff_w_out[j], lambda_init)
        h = h + _ple(h, p[i], ple_norm[i], ple_w_gate[i], ple_w_proj[i])
        if i == N_A - 1:
            k1, k2, v = _shared_kv(h, kv_norm, w_kv)
    return _rmsnorm(h, final_norm)
```

```cpp
#include <hip/hip_runtime.h>
#include <hip/hip_cooperative_groups.h>
#include <cstdio>
#include <cstdint>
namespace cg = cooperative_groups;
namespace pg8 {
#define PG8_LAS __attribute__((address_space(3)))
typedef unsigned short bf16_t;
typedef short bf16x8 __attribute__((ext_vector_type(8)));
typedef float f32x4 __attribute__((ext_vector_type(4)));
typedef unsigned u32x4 __attribute__((ext_vector_type(4)));
constexpr int BM = 256, BK = 64, HALF = 128, HTB = HALF * BK * 2  , STAGE_BYTES = 8 * HTB, NXCD = 8, WGM = 4;

__host__ __device__ __forceinline__ int lds_byte(int r, int c) { const int st = (r >> 4) * 2 + (c >> 5), rr = r & 15, cc = c & 31, ob = rr * 64 + cc * 2; return st * 1024 + (ob ^ (((ob >> 9) & 1) << 5)); }
__host__ __device__ __forceinline__ void stage_rc(int b, int& R, int& C) { const int st = b / 1024, sb = b % 1024, swz = sb ^ (((sb >> 9) & 1) << 5); R = (st >> 1) * 16 + swz / 64; C = (st & 1) * 32 + (swz % 64) / 2; }
__host__ __device__ __forceinline__ int perm32(int rho) { const int n = rho >> 4, i = rho & 15; return 8 * (i >> 2) + 4 * n + (i & 3); }

struct Unit { int pm, pn; };
struct Gemm { const bf16_t* A; const bf16_t* Bt; int M, N, K; };

struct StaticOrder {
    int nM, nN, nwg, G, c;
    __host__ __device__ void init(int M, int N, int G_, int c_) { nM = M / BM; nN = N / BM; nwg = nM * nN; G = G_; c = c_; }
    __host__ __device__ bool next(int i, Unit& u) const {
        const long L = (long)i * G + c; if (L >= nwg) return false;
        int wgid = (int)L; { const int q = nwg / NXCD, r = nwg % NXCD, xcd = wgid % NXCD, off = wgid / NXCD; wgid = (xcd < r ? xcd * (q + 1) : r * (q + 1) + (xcd - r) * q) + off; }
        const int nig = WGM * nN, gid = wgid / nig, fm = gid * WGM, gsz = (nM - fm) < WGM ? (nM - fm) : WGM;
        u.pm = fm + ((wgid % nig) % gsz); u.pn = (wgid % nig) / gsz; return true;
    }
    __device__ __forceinline__ void a_ready(const Unit&) const {}
    __device__ __forceinline__ void done(const Unit&) const {}
};

template <class Epi, class Sched, bool ALIGN_EPI = false, bool SP2 = false>
__device__ __forceinline__ void gemm_phase(PG8_LAS unsigned char* lds, const Gemm g, const Sched& S, const Epi& E, int wv) {
    int tid_; { int l_; asm volatile("v_mbcnt_lo_u32_b32 %0, -1, 0\n\tv_mbcnt_hi_u32_b32 %0, -1, %0" : "=v"(l_)); tid_ = wv * 64 + l_; }
    const int tid = tid_, wid = __builtin_amdgcn_readfirstlane(tid >> 6), lane = tid & 63, wr = wid >> 2, wc = wid & 3, fr = lane & 15, fq = lane >> 4;
    const int K = g.K, nt = K / BK;
    unsigned voffA[2], voffB[2];
#pragma unroll
    for (int i = 0; i < 2; ++i) { int R, C; stage_rc(tid * 16 + i * 8192, R, C); const int Rb = Epi::PERM ? ((R & ~31) + perm32(R & 31)) : R;
        voffA[i] = (unsigned)(R * K + C) * 2u; voffB[i] = (unsigned)(Rb * K + C) * 2u; }
    const size_t kstep = (size_t)(BK * 2);
    const size_t hstep = (size_t)HALF * K * 2;
    const size_t tstep = 2 * hstep;
    const unsigned ldsw = (unsigned)wid * 1024u;
    const int aoff = lds_byte(wr * 64 + fr, fq * 8), boff = lds_byte(wc * 32 + fr, fq * 8);
#define PG8_SA(b, h) (((b) * 2 + (h)) * HTB)
#define PG8_SB(b, h) ((4 + (b) * 2 + (h)) * HTB)
#define PG8_STAGE(bufoff, gbase, voff) do { _Pragma("unroll") for (int _i = 0; _i < 2; ++_i) \
        __builtin_amdgcn_global_load_lds((const unsigned*)((const char*)(gbase) + (voff)[_i]), (PG8_LAS unsigned*)(lds + (bufoff) + ldsw + _i * 8192), 16, 0, 0); } while (0)
#define PG8_LDA(dst, b, h) do { _Pragma("unroll") for (int m = 0; m < 4; ++m) _Pragma("unroll") for (int k = 0; k < 2; ++k) dst[m][k] = *(const PG8_LAS bf16x8*)(lds + PG8_SA(b, h) + aoff + m * 2048 + k * 1024); } while (0)
#define PG8_LDB(dst, b, h) do { _Pragma("unroll") for (int n = 0; n < 2; ++n) _Pragma("unroll") for (int k = 0; k < 2; ++k) dst[n][k] = *(const PG8_LAS bf16x8*)(lds + PG8_SB(b, h) + boff + n * 2048 + k * 1024); } while (0)
#define PG8_MMA(ai, bj, At, Bt) do { __builtin_amdgcn_s_setprio(1); _Pragma("unroll") for (int m = 0; m < 4; ++m) _Pragma("unroll") for (int n = 0; n < 2; ++n) _Pragma("unroll") for (int k = 0; k < 2; ++k) \
        acc[ai][bj][m][n] = __builtin_amdgcn_mfma_f32_16x16x32_bf16(Bt[n][k], At[m][k], acc[ai][bj][m][n], 0, 0, 0); __builtin_amdgcn_s_setprio(0); } while (0)
#define PG8_WAIT_V(n) asm volatile("s_waitcnt vmcnt(" #n ")" ::: "memory")
#define PG8_WAIT_L(n) asm volatile("s_waitcnt lgkmcnt(" #n ")" ::: "memory")
#define PG8_BAR __builtin_amdgcn_s_barrier()
#define PG8_SCHED __builtin_amdgcn_sched_barrier(0)
    Unit cur, nxt; int ui = 0;
    if (!S.next(0, cur)) return;
    f32x4 acc[2][2][4][2];
#pragma unroll
    for (int a = 0; a < 2; ++a)
#pragma unroll
        for (int b = 0; b < 2; ++b)
#pragma unroll
            for (int m = 0; m < 4; ++m)
#pragma unroll
                for (int n = 0; n < 2; ++n) acc[a][b][m][n] = (f32x4){0.f, 0.f, 0.f, 0.f};
    bf16x8 At[4][2], B0[2][2], B1[2][2];
    const char* cA = (const char*)g.A + (size_t)cur.pm * tstep; const char* cB = (const char*)g.Bt + (size_t)cur.pn * tstep;
    S.a_ready(cur);
    if constexpr (SP2) {
        PG8_STAGE(PG8_SB(0, 0), cB, voffB); PG8_STAGE(PG8_SB(0, 1), cB + hstep, voffB); PG8_STAGE(PG8_SA(0, 0), cA, voffA); PG8_STAGE(PG8_SA(0, 1), cA + hstep, voffA);
        if (wr == 1) PG8_BAR;
        PG8_WAIT_V(2); PG8_BAR;
        PG8_STAGE(PG8_SB(1, 0), cB + kstep, voffB); PG8_STAGE(PG8_SA(1, 0), cA + kstep, voffA); PG8_STAGE(PG8_SB(1, 1), cB + hstep + kstep, voffB);
        PG8_WAIT_V(6); PG8_BAR;
    } else {
        PG8_STAGE(PG8_SB(0, 0), cB, voffB); PG8_STAGE(PG8_SA(0, 0), cA, voffA); PG8_STAGE(PG8_SB(0, 1), cB + hstep, voffB); PG8_STAGE(PG8_SA(0, 1), cA + hstep, voffA);
        if (wr == 1) PG8_BAR;
        PG8_WAIT_V(4); PG8_BAR;
        PG8_STAGE(PG8_SB(1, 0), cB + kstep, voffB); PG8_STAGE(PG8_SA(1, 0), cA + kstep, voffA); PG8_STAGE(PG8_SB(1, 1), cB + hstep + kstep, voffB);
        PG8_WAIT_V(6); PG8_BAR;
    }
    for (;;) {
        const bool has_next = S.next(ui + 1, nxt);
        const char* nA = has_next ? (const char*)g.A + (size_t)nxt.pm * tstep : cA; const char* nB = has_next ? (const char*)g.Bt + (size_t)nxt.pn * tstep : cB;
        for (int t = 0; t < nt; t += 2) {
            const bool last = (t == nt - 2);
            const char* a1 = cA + (size_t)(t + 1) * kstep;
            const char* a2 = last ? nA : cA + (size_t)(t + 2) * kstep; const char* b2 = last ? nB : cB + (size_t)(t + 2) * kstep;
            const char* a3 = a2 + kstep; const char* b3 = b2 + kstep;
            if (last && has_next) S.a_ready(nxt);
            if constexpr (SP2) {
            PG8_LDB(B0, 0, 0); PG8_LDB(B1, 0, 1); PG8_SCHED; PG8_LDA(At, 0, 0); PG8_STAGE(PG8_SA(1, 1), a1 + hstep, voffA);
            PG8_WAIT_V(8); PG8_WAIT_L(0); PG8_BAR; PG8_MMA(0, 0, At, B0); PG8_MMA(0, 1, At, B1); PG8_BAR; PG8_SCHED;
            PG8_LDA(At, 0, 1); PG8_STAGE(PG8_SB(0, 0), b2, voffB); PG8_STAGE(PG8_SB(0, 1), b2 + hstep, voffB); PG8_STAGE(PG8_SA(0, 0), a2, voffA);
            PG8_WAIT_V(8); PG8_WAIT_L(0); PG8_BAR; PG8_MMA(1, 0, At, B0); PG8_MMA(1, 1, At, B1); PG8_BAR; PG8_SCHED;
            PG8_LDB(B0, 1, 0); PG8_LDB(B1, 1, 1); PG8_SCHED; PG8_LDA(At, 1, 0); PG8_STAGE(PG8_SA(0, 1), a2 + hstep, voffA);
            PG8_WAIT_V(8); PG8_WAIT_L(0); PG8_BAR; PG8_MMA(0, 0, At, B0); PG8_MMA(0, 1, At, B1); PG8_BAR; PG8_SCHED;
            PG8_LDA(At, 1, 1); PG8_STAGE(PG8_SB(1, 0), b3, voffB); PG8_STAGE(PG8_SB(1, 1), b3 + hstep, voffB); PG8_STAGE(PG8_SA(1, 0), a3, voffA);
            PG8_WAIT_V(8); PG8_WAIT_L(0); PG8_BAR; PG8_MMA(1, 0, At, B0); PG8_MMA(1, 1, At, B1); PG8_BAR; PG8_SCHED;
            } else {
            PG8_LDB(B0, 0, 0); PG8_SCHED; PG8_LDA(At, 0, 0); PG8_STAGE(PG8_SA(1, 1), a1 + hstep, voffA);
            PG8_WAIT_L(8); PG8_BAR; PG8_WAIT_L(0); PG8_MMA(0, 0, At, B0); PG8_BAR; PG8_SCHED;
            PG8_LDB(B1, 0, 1); PG8_STAGE(PG8_SB(0, 0), b2, voffB);
            PG8_BAR; PG8_WAIT_L(0); PG8_MMA(0, 1, At, B1); PG8_BAR;
            PG8_LDA(At, 0, 1); PG8_STAGE(PG8_SA(0, 0), a2, voffA);
            PG8_BAR; PG8_WAIT_L(0); PG8_MMA(1, 0, At, B0); PG8_BAR; PG8_SCHED;
            PG8_STAGE(PG8_SB(0, 1), b2 + hstep, voffB);
            PG8_WAIT_V(6); PG8_BAR; PG8_MMA(1, 1, At, B1); PG8_BAR;
            PG8_LDB(B0, 1, 0); PG8_SCHED; PG8_LDA(At, 1, 0); PG8_STAGE(PG8_SA(0, 1), a2 + hstep, voffA);
            PG8_WAIT_L(8); PG8_BAR; PG8_WAIT_L(0); PG8_MMA(0, 0, At, B0); PG8_BAR; PG8_SCHED;
            PG8_LDB(B1, 1, 1); PG8_STAGE(PG8_SB(1, 0), b3, voffB);
            PG8_BAR; PG8_WAIT_L(0); PG8_MMA(0, 1, At, B1); PG8_BAR;
            PG8_LDA(At, 1, 1); PG8_STAGE(PG8_SA(1, 0), a3, voffA);
            PG8_BAR; PG8_WAIT_L(0); PG8_MMA(1, 0, At, B0); PG8_BAR; PG8_SCHED;
            PG8_STAGE(PG8_SB(1, 1), b3 + hstep, voffB);
            PG8_WAIT_V(6); PG8_BAR; PG8_MMA(1, 1, At, B1); PG8_BAR;
            }
        }
        if constexpr (ALIGN_EPI) { if (wr == 0) PG8_BAR; }
        if constexpr (!Epi::AFTER_DRAIN) { E(acc, cur, wr, wc, fr, fq); S.done(cur); }
        if (!has_next) break;
#pragma unroll
        for (int a = 0; a < 2; ++a)
#pragma unroll
            for (int b = 0; b < 2; ++b)
#pragma unroll
                for (int m = 0; m < 4; ++m)
#pragma unroll
                    for (int n = 0; n < 2; ++n) acc[a][b][m][n] = (f32x4){0.f, 0.f, 0.f, 0.f};
        cur = nxt; cA = nA; cB = nB; ++ui;
        if constexpr (ALIGN_EPI) { if (wr == 1) PG8_BAR; }
    }
    PG8_WAIT_V(0);
    if constexpr (!ALIGN_EPI) { if (wr == 0) PG8_BAR; }
    PG8_BAR;
    if constexpr (Epi::AFTER_DRAIN) { E.fused(acc, cur, wr, wc, fr, fq, lds, wid, lane); S.done(cur); }
#undef PG8_SA
#undef PG8_SB
#undef PG8_STAGE
#undef PG8_LDA
#undef PG8_LDB
#undef PG8_MMA
#undef PG8_WAIT_V
#undef PG8_WAIT_L
#undef PG8_BAR
#undef PG8_SCHED
}
}

#define LAS __attribute__((address_space(3)))
typedef unsigned short bf16_t;
typedef short bf16x8 __attribute__((ext_vector_type(8)));
typedef float f32x4 __attribute__((ext_vector_type(4)));
typedef float f32x2 __attribute__((ext_vector_type(2)));
typedef float f32x16 __attribute__((ext_vector_type(16)));
typedef unsigned u32x4 __attribute__((ext_vector_type(4)));
typedef unsigned u32x2 __attribute__((ext_vector_type(2)));
typedef __bf16 bf16x2_t __attribute__((ext_vector_type(2)));
using pg8::Unit;

constexpr int DM = 1024, SEQ = 4096, NB = 8, MIX = 2048, PLE = 256;
constexpr int TH = 4 * SEQ;
constexpr int GLA_NCOL = 6160, GLA_N = 6400;
constexpr float EPS = 1e-6f;
constexpr int LDS_BYTES = 147456;
constexpr int PTAB_OFF = LDS_BYTES - 256;

constexpr size_t MiB = 1u << 20;
constexpr size_t WS_WGLAIN = 1 * MiB;
constexpr size_t WS_WGLAOUT = 29 * MiB;
constexpr size_t WS_WKV = 37 * MiB;
constexpr size_t WS_WDIN = 45 * MiB;
constexpr size_t WS_WDOUT = 61 * MiB;
constexpr size_t WS_WPG = 69 * MiB;
constexpr size_t WS_WPP = 77 * MiB;
constexpr size_t WS_HBB = 80 * MiB;
constexpr size_t WS_RSB = 112 * MiB;
constexpr size_t WS_PBF = 113 * MiB;
constexpr size_t WS_GBUF = 121 * MiB;
constexpr size_t WS_HSS = 153 * MiB;
constexpr size_t WS_R0 = 160 * MiB;
constexpr size_t WS_R1 = 192 * MiB;
constexpr size_t WS_R2 = 224 * MiB;
constexpr size_t WS_R3 = 288 * MiB;
constexpr size_t WS_R4 = 352 * MiB;
constexpr size_t WS_HBA = 416 * MiB;
constexpr size_t WS_RSA = 448 * MiB;
constexpr size_t WS_END = 449 * MiB;

__device__ __forceinline__ unsigned pk_bf16(float lo, float hi) { f32x2 v = {lo, hi}; bf16x2_t b = __builtin_convertvector(v, bf16x2_t); return __builtin_bit_cast(unsigned, b); }
__device__ __forceinline__ float bf_lo(unsigned w) { return __uint_as_float(w << 16); }
__device__ __forceinline__ float bf_hi(unsigned w) { return __uint_as_float(w & 0xffff0000u); }
__device__ __forceinline__ float fast_exp(float x) { return __builtin_amdgcn_exp2f(x * 1.4426950408889634f); }
__device__ __forceinline__ float sigmoidf_(float x) { return __builtin_amdgcn_rcpf(1.f + fast_exp(-x)); }
__device__ __forceinline__ int lane_op() { int l; asm volatile("v_mbcnt_lo_u32_b32 %0, -1, 0\n\tv_mbcnt_hi_u32_b32 %0, -1, %0" : "=v"(l)); return l; }
__device__ __forceinline__ float shx(float v, int m) { return __builtin_bit_cast(float, __builtin_amdgcn_ds_bpermute((lane_op() ^ m) << 2, __builtin_bit_cast(int, v))); }
__device__ __forceinline__ float shl_(float v, int src) { return __builtin_bit_cast(float, __builtin_amdgcn_ds_bpermute(src << 2, __builtin_bit_cast(int, v))); }
__device__ __forceinline__ float x32_sum(float v) { auto rr = __builtin_amdgcn_permlane32_swap(__float_as_uint(v), __float_as_uint(v), false, false); return __uint_as_float(rr[0]) + __uint_as_float(rr[1]); }
__device__ __forceinline__ float x32_max(float v) { auto rr = __builtin_amdgcn_permlane32_swap(__float_as_uint(v), __float_as_uint(v), false, false); return fmaxf(__uint_as_float(rr[0]), __uint_as_float(rr[1])); }
__device__ __forceinline__ float wave_sum(float v) {
#pragma unroll
    for (int o = 1; o < 64; o <<= 1) v += shx(v, o);
    return v;
}
__device__ __forceinline__ float row_rstd(const float* rs, int r) {
    const f32x4* p = (const f32x4*)(rs + (size_t)r * 16);
    const f32x4 a = p[0], b = p[1], c = p[2], d = p[3];
    const float s = ((a[0] + a[1]) + (a[2] + a[3])) + ((b[0] + b[1]) + (b[2] + b[3])) + ((c[0] + c[1]) + (c[2] + c[3])) + ((d[0] + d[1]) + (d[2] + d[3]));
    return __builtin_amdgcn_rsqf(s * (1.f / DM) + EPS);
}

__device__ __forceinline__ f32x4 act4(f32x4 v, int act) {
    if (act == 1) { v[0] *= sigmoidf_(v[0]); v[1] *= sigmoidf_(v[1]); v[2] *= sigmoidf_(v[2]); v[3] *= sigmoidf_(v[3]); }
    if (act == 2) { v[0] = sigmoidf_(v[0]); v[1] = sigmoidf_(v[1]); v[2] = sigmoidf_(v[2]); v[3] = sigmoidf_(v[3]); }
    return v;
}
template <int ACT>
__device__ __forceinline__ void epi_store_bf16(const f32x4 (&acc)[2][2][4][2], bf16_t* base, int ldc, int row0, int col0, const float (&rs)[2][4], float scale) {
#pragma unroll
    for (int ai = 0; ai < 2; ++ai)
#pragma unroll
        for (int m = 0; m < 4; ++m) {
            bf16_t* rowp = base + (size_t)(row0 + ai * 128 + m * 16) * ldc + col0; const float s = rs[ai][m] * scale;
#pragma unroll
            for (int bj = 0; bj < 2; ++bj) {
                const f32x4 v0 = act4(acc[ai][bj][m][0] * s, ACT), v1 = act4(acc[ai][bj][m][1] * s, ACT);
                u32x4 w; w.x = pk_bf16(v0[0], v0[1]); w.y = pk_bf16(v0[2], v0[3]); w.z = pk_bf16(v1[0], v1[1]); w.w = pk_bf16(v1[2], v1[3]);
                *(u32x4*)(rowp + bj * 128) = w;
            }
        }
}
__device__ __forceinline__ void load_rs(float (&rs)[2][4], const float* rowss, int row0, int fq) {
#pragma unroll
    for (int ai = 0; ai < 2; ++ai)
#pragma unroll
        for (int m = 0; m < 4; ++m) {
            const f32x4 a = *((const f32x4*)(rowss + (size_t)(row0 + ai * 128 + m * 16) * 16) + fq);
            float s = (a[0] + a[1]) + (a[2] + a[3]); s += shx(s, 16); s = x32_sum(s);
            rs[ai][m] = __builtin_amdgcn_rsqf(s * (1.f / DM) + EPS);
        }
}

struct EpiGlaIn {
    static constexpr bool PERM = true, AFTER_DRAIN = false;
    const float* rowss; bf16_t *Q, *K, *V, *G;
    __device__ __forceinline__ void operator()(const f32x4 (&acc)[2][2][4][2], const Unit& u, int wr, int wc, int fr, int fq) const {
        const int row0 = u.pm * 256 + wr * 64 + fr, cw = wc * 32 + 8 * fq, pn = u.pn;
        float rs[2][4]; load_rs(rs, rowss, row0, fq);
        if (pn < 4) epi_store_bf16<0>(acc, Q, DM, row0, pn * 256 + cw, rs, 0.0625f);
        else if (pn < 8) epi_store_bf16<0>(acc, K, DM, row0, (pn - 4) * 256 + cw, rs, 1.f);
        else if (pn < 16) epi_store_bf16<0>(acc, V, MIX, row0, (pn - 8) * 256 + cw, rs, 1.f);
        else epi_store_bf16<1>(acc, G, MIX, row0, (pn - 16) * 256 + cw, rs, 1.f);
    }
};
template <int ACT1>
struct EpiProj2 {
    static constexpr bool PERM = true, AFTER_DRAIN = false;
    const float* rowss; bf16_t *O0, *O1; int nsplit; float scale0;
    __device__ __forceinline__ void operator()(const f32x4 (&acc)[2][2][4][2], const Unit& u, int wr, int wc, int fr, int fq) const {
        const int row0 = u.pm * 256 + wr * 64 + fr, cw = wc * 32 + 8 * fq, pn = u.pn;
        float rs[2][4]; load_rs(rs, rowss, row0, fq);
        if (pn < nsplit) epi_store_bf16<0>(acc, O0, MIX, row0, pn * 256 + cw, rs, scale0);
        else epi_store_bf16<ACT1>(acc, O1, MIX, row0, (pn - nsplit) * 256 + cw, rs, 1.f);
    }
};
struct EpiVT {
    static constexpr bool PERM = true, AFTER_DRAIN = false;
    const float* rowss; bf16_t* VT;
    __device__ __forceinline__ void operator()(const f32x4 (&acc)[2][2][4][2], const Unit& u, int wr, int wc, int fr, int fq) const {
        const int row0 = u.pm * 256 + wr * 64 + fr, col0 = u.pn * 256 + wc * 32 + 8 * fq;
        const float mine = row_rstd(rowss, col0 + (fr >> 3) * 128 + (fr & 7));
#pragma unroll
        for (int bj = 0; bj < 2; ++bj) {
            const int c = col0 + bj * 128, src = fq * 16 + bj * 8;
            f32x4 s0, s1;
            s0[0] = shl_(mine, src); s0[1] = shl_(mine, src + 1); s0[2] = shl_(mine, src + 2); s0[3] = shl_(mine, src + 3);
            s1[0] = shl_(mine, src + 4); s1[1] = shl_(mine, src + 5); s1[2] = shl_(mine, src + 6); s1[3] = shl_(mine, src + 7);
#pragma unroll
            for (int ai = 0; ai < 2; ++ai)
#pragma unroll
                for (int m = 0; m < 4; ++m) {
                    const f32x4 v0 = acc[ai][bj][m][0] * s0, v1 = acc[ai][bj][m][1] * s1;
                    u32x4 w; w.x = pk_bf16(v0[0], v0[1]); w.y = pk_bf16(v0[2], v0[3]); w.z = pk_bf16(v1[0], v1[1]); w.w = pk_bf16(v1[2], v1[3]);
                    const int ch = row0 + ai * 128 + m * 16;
                    *(u32x4*)(VT + ((((size_t)((c >> 12) * 8 + (ch >> 8)) * 128 + ((c & 4095) >> 5)) * 256 + (ch & 255)) * 32 + (c & 31))) = w;
                }
        }
    }
};
struct EpiGate {
    static constexpr bool PERM = true, AFTER_DRAIN = false;
    const float* rowss; bf16_t* Gb;
    __device__ __forceinline__ void operator()(const f32x4 (&acc)[2][2][4][2], const Unit& u, int wr, int wc, int fr, int fq) const {
        const int row0 = u.pm * 256 + wr * 64 + fr;
        float rs[2][4]; load_rs(rs, rowss, row0, fq);
        epi_store_bf16<2>(acc, Gb, DM, row0, u.pn * 256 + wc * 32 + 8 * fq, rs, 1.f);
    }
};
template <bool GATED>
struct EpiResid {
    static constexpr bool PERM = true, AFTER_DRAIN = false;
    const float* Hs; float* H; bf16_t* HB; float* rowss; const bf16_t* Gb;
    __device__ __forceinline__ void operator()(const f32x4 (&acc)[2][2][4][2], const Unit& u, int wr, int wc, int fr, int fq) const {
        const int row0 = u.pm * 256 + wr * 64 + fr, col0 = u.pn * 256 + wc * 32 + 8 * fq;
#pragma unroll
        for (int ai = 0; ai < 2; ++ai)
#pragma unroll
            for (int m = 0; m < 4; ++m) {
                const int row = row0 + ai * 128 + m * 16; float ss = 0.f;
#pragma unroll
                for (int bj = 0; bj < 2; ++bj) {
                    const size_t off = (size_t)row * DM + col0 + bj * 128;
                    f32x4 h0 = *(const f32x4*)(Hs + off), h1 = *(const f32x4*)(Hs + off + 4); f32x4 a0 = acc[ai][bj][m][0], a1 = acc[ai][bj][m][1];
                    if (GATED) {
                        const unsigned long long ga = __hip_atomic_load((const unsigned long long*)(Gb + off), __ATOMIC_RELAXED, __HIP_MEMORY_SCOPE_AGENT);
                        const unsigned long long gb = __hip_atomic_load((const unsigned long long*)(Gb + off + 4), __ATOMIC_RELAXED, __HIP_MEMORY_SCOPE_AGENT);
                        const unsigned g0 = (unsigned)ga, g1 = (unsigned)(ga >> 32), g2 = (unsigned)gb, g3 = (unsigned)(gb >> 32);
                        a0[0] *= bf_lo(g0); a0[1] *= bf_hi(g0); a0[2] *= bf_lo(g1); a0[3] *= bf_hi(g1);
                        a1[0] *= bf_lo(g2); a1[1] *= bf_hi(g2); a1[2] *= bf_lo(g3); a1[3] *= bf_hi(g3);
                    }
                    h0 += a0; h1 += a1;
                    *(f32x4*)(H + off) = h0; *(f32x4*)(H + off + 4) = h1;
                    u32x4 w; w.x = pk_bf16(h0[0], h0[1]); w.y = pk_bf16(h0[2], h0[3]); w.z = pk_bf16(h1[0], h1[1]); w.w = pk_bf16(h1[2], h1[3]);
                    *(u32x4*)(HB + off) = w;
                    ss += ((h0[0] * h0[0] + h0[1] * h0[1]) + (h0[2] * h0[2] + h0[3] * h0[3])) + ((h1[0] * h1[0] + h1[1] * h1[1]) + (h1[2] * h1[2] + h1[3] * h1[3]));
                }
                ss += shx(ss, 16); ss = x32_sum(ss);
                if (fq == 0) rowss[(size_t)row * 16 + u.pn * 4 + wc] = ss;
                asm volatile("" ::: "memory");
            }
    }
};

template <class Epi>
__device__ __forceinline__ void run_gemm_(int wv, LAS unsigned char* lds, const bf16_t* A, const bf16_t* Bt, int M, int N, int K, const Epi& E) {
    pg8::Gemm g{A, Bt, M, N, K}; pg8::StaticOrder S; S.init(M, N, (int)gridDim.x, (int)blockIdx.x);
    pg8::gemm_phase<Epi, pg8::StaticOrder, true, true>(lds, g, S, E, wv);
}

__device__ __forceinline__ void transpose_item(const float* W, int ldn, int ncols, int K, const float* scale, bf16_t* WT, LAS float* scr, int item, int lane) {
    const int nblk = ncols / 32, kb = item / nblk, nb = item % nblk, k0 = 64 * kb, n0 = 32 * nb;
#pragma unroll
    for (int i = 0; i < 8; ++i) { const int kk = 8 * i + (lane >> 3), n4 = (lane & 7) * 4; f32x4 v = __builtin_nontemporal_load((const f32x4*)(W + (size_t)(k0 + kk) * ldn + n0 + n4)); if (scale) v *= scale[k0 + kk];
        LAS float* d = scr + kk * 33 + n4; d[0] = v[0]; d[1] = v[1]; d[2] = v[2]; d[3] = v[3]; }
    asm volatile("s_waitcnt lgkmcnt(0)" ::: "memory");
    const int c = lane & 7;
#pragma unroll
    for (int j = 0; j < 4; ++j) { const int n = (lane >> 3) + 8 * j; const LAS float* s = scr + (8 * c) * 33 + n;
        u32x4 o; o.x = pk_bf16(s[0 * 33], s[1 * 33]); o.y = pk_bf16(s[2 * 33], s[3 * 33]); o.z = pk_bf16(s[4 * 33], s[5 * 33]); o.w = pk_bf16(s[6 * 33], s[7 * 33]);
        *(u32x4*)(WT + (size_t)(n0 + n) * K + k0 + 8 * c) = o; }
    asm volatile("s_waitcnt lgkmcnt(0)" ::: "memory");
}

struct Params {
    const float *x, *p, *norm_mix, *gla_w_in, *gla_w_gk2, *gla_b_gk, *gla_norm, *gla_w_out, *kv_norm, *w_kv, *diff_w_in, *diff_lambda, *diff_norm, *diff_w_out,
        *ple_norm, *ple_w_gate, *ple_w_proj, *final_norm;
    float* out; unsigned char* ws;
};

__device__ __forceinline__ void prologue_weights(const Params& a, LAS unsigned char* lds, int tid) {
    asm volatile("" : "+v"(tid));
    const int lane = tid & 63, wave = tid >> 6;
    LAS float* scr = (LAS float*)(lds + wave * 16384);
    const int gw = (int)blockIdx.x * 8 + wave, NGW = (int)gridDim.x * 8;
    unsigned char* ws = a.ws;
    constexpr int I_GIN = 16 * 192, I_GOUT = 32 * 32, I_KV = 16 * 128, I_DIN = 16 * 128, I_DOUT = 32 * 32, I_PG = 16 * 32, I_PP = 4 * 32;
    constexpr int NITEMS = 2 * I_GIN + 2 * I_GOUT + I_KV + 2 * I_DIN + 2 * I_DOUT + 4 * I_PG + 4 * I_PP;
    for (int it = gw; it < NITEMS; it += NGW) {
        int r = it;
        if (r < 2 * I_GIN) { const int i = r / I_GIN; r -= i * I_GIN;
            transpose_item(a.gla_w_in + (size_t)i * DM * GLA_NCOL, GLA_NCOL, 6144, DM, a.norm_mix + i * DM, (bf16_t*)(ws + WS_WGLAIN) + (size_t)i * GLA_N * DM, scr, r, lane); continue; }
        r -= 2 * I_GIN;
        if (r < 2 * I_GOUT) { const int i = r / I_GOUT; r -= i * I_GOUT;
            transpose_item(a.gla_w_out + (size_t)i * MIX * DM, DM, DM, MIX, nullptr, (bf16_t*)(ws + WS_WGLAOUT) + (size_t)i * DM * MIX, scr, r, lane); continue; }
        r -= 2 * I_GOUT;
        if (r < I_KV) { transpose_item(a.w_kv, 4096, 4096, DM, a.kv_norm, (bf16_t*)(ws + WS_WKV), scr, r, lane); continue; }
        r -= I_KV;
        if (r < 2 * I_DIN) { const int i = r / I_DIN; r -= i * I_DIN;
            transpose_item(a.diff_w_in + (size_t)i * DM * 4096, 4096, 4096, DM, a.norm_mix + (2 + i) * DM, (bf16_t*)(ws + WS_WDIN) + (size_t)i * 4096 * DM, scr, r, lane); continue; }
        r -= 2 * I_DIN;
        if (r < 2 * I_DOUT) { const int i = r / I_DOUT; r -= i * I_DOUT;
            transpose_item(a.diff_w_out + (size_t)i * MIX * DM, DM, DM, MIX, nullptr, (bf16_t*)(ws + WS_WDOUT) + (size_t)i * DM * MIX, scr, r, lane); continue; }
        r -= 2 * I_DOUT;
        if (r < 4 * I_PG) { const int i = r / I_PG; r -= i * I_PG;
            transpose_item(a.ple_w_gate + (size_t)i * DM * DM, DM, DM, DM, a.ple_norm + i * DM, (bf16_t*)(ws + WS_WPG) + (size_t)i * DM * DM, scr, r, lane); continue; }
        r -= 4 * I_PG;
        { const int i = r / I_PP; r -= i * I_PP;
            transpose_item(a.ple_w_proj + (size_t)i * PLE * DM, DM, DM, PLE, nullptr, (bf16_t*)(ws + WS_WPP) + (size_t)i * DM * PLE, scr, r, lane); }
    }
    const int gt = (int)blockIdx.x * 512 + tid, NGT = (int)gridDim.x * 512;
    for (int id = gt; id < 2 * 256 * 128; id += NGT) {
        const int i = id >> 15, rem = id & 32767, r = rem >> 7, k0 = (rem & 127) * 8;
        u32x4 w = {0u, 0u, 0u, 0u};
        if (r < 16) {
            const float* win = a.gla_w_in + (size_t)i * DM * GLA_NCOL + 6144 + r; const float* nm = a.norm_mix + i * DM + k0;
            float o[8];
#pragma unroll
            for (int jj = 0; jj < 8; ++jj) o[jj] = win[(size_t)(k0 + jj) * GLA_NCOL] * nm[jj];
            w.x = pk_bf16(o[0], o[1]); w.y = pk_bf16(o[2], o[3]); w.z = pk_bf16(o[4], o[5]); w.w = pk_bf16(o[6], o[7]);
        }
        *(u32x4*)((bf16_t*)(ws + WS_WGLAIN) + (size_t)i * GLA_N * DM + (size_t)(6144 + r) * DM + k0) = w;
    }
}

__device__ __forceinline__ void init_rows(const float* xh, bf16_t* HB, float* rowss, int tid) {
    asm volatile("" : "+v"(tid));
    const int lane = tid & 63, gw = (int)blockIdx.x * 8 + (tid >> 6), NGW = (int)gridDim.x * 8;
    for (int r = gw; r < TH; r += NGW) {
        const f32x4* xr = (const f32x4*)(xh + (size_t)r * DM) + lane; u32x2* br = (u32x2*)(HB + (size_t)r * DM) + lane;
        float s = 0.f;
#pragma unroll
        for (int j = 0; j < 4; ++j) { const f32x4 v = __builtin_nontemporal_load(xr + 64 * j); u32x2 w; w.x = pk_bf16(v[0], v[1]); w.y = pk_bf16(v[2], v[3]); br[64 * j] = w; s += (v[0] * v[0] + v[1] * v[1]) + (v[2] * v[2] + v[3] * v[3]); }
        s = wave_sum(s);
        if (lane < 16) rowss[(size_t)r * 16 + lane] = (lane == 0) ? s : 0.f;
    }
}
__device__ __forceinline__ void final_rows(float* H, const float* gain, int tid) {
    asm volatile("" : "+v"(tid));
    const int lane = tid & 63, gw = (int)blockIdx.x * 8 + (tid >> 6), NGW = (int)gridDim.x * 8;
    for (int r = gw; r < TH; r += NGW) {
        f32x4* hr = (f32x4*)(H + (size_t)r * DM) + lane; const f32x4* gr = (const f32x4*)gain + lane;
        f32x4 v[4]; float s = 0.f;
#pragma unroll
        for (int j = 0; j < 4; ++j) { v[j] = __builtin_nontemporal_load(hr + 64 * j); s += (v[j][0] * v[j][0] + v[j][1] * v[j][1]) + (v[j][2] * v[j][2] + v[j][3] * v[j][3]); }
        const float rstd = 1.f / sqrtf(wave_sum(s) * (1.f / DM) + EPS);
#pragma unroll
        for (int j = 0; j < 4; ++j) __builtin_nontemporal_store(v[j] * rstd * gr[64 * j], hr + 64 * j);
    }
}
__device__ __forceinline__ void convert_p(const float* ph, bf16_t* PBF, int tid) {
    asm volatile("" : "+v"(tid));
    const int gt = (int)blockIdx.x * 512 + tid, NGT = (int)gridDim.x * 512;
    for (int i = gt; i < TH * PLE / 8; i += NGT) {
        const f32x4 a = __builtin_nontemporal_load((const f32x4*)ph + 2 * i), b = __builtin_nontemporal_load((const f32x4*)ph + 2 * i + 1);
        u32x4 w; w.x = pk_bf16(a[0], a[1]); w.y = pk_bf16(a[2], a[3]); w.z = pk_bf16(b[0], b[1]); w.w = pk_bf16(b[2], b[3]);
        ((u32x4*)PBF)[i] = w;
    }
}
__device__ __forceinline__ void gla_norm_gate(bf16_t* VO, const bf16_t* SG, const float* HSS, const float* gnorm, int tid) {
    asm volatile("" : "+v"(tid));
    const int lane = tid & 63, gw = (int)blockIdx.x * 8 + (tid >> 6), NGW = (int)gridDim.x * 8;
    const f32x4 g0 = *(const f32x4*)(gnorm + lane * 8), g1 = *(const f32x4*)(gnorm + lane * 8 + 4);
    for (int r = gw; r < TH; r += NGW) {
        const float hp = HSS[(size_t)r * 64 + lane];
        float hs = hp; hs += shx(hs, 1); hs += shx(hs, 2); hs += shx(hs, 4); hs += shx(hs, 8);
#pragma unroll
        for (int j = 0; j < 4; ++j) {
            const float rstd = __builtin_amdgcn_rsqf(shl_(hs, j * 16) * (1.f / 512.f) + EPS);
            u32x4* op = (u32x4*)(VO + (size_t)r * MIX + j * 512 + lane * 8); const u32x4 o = *op; const u32x4 s = *(const u32x4*)(SG + (size_t)r * MIX + j * 512 + lane * 8);
            u32x4 w;
            w.x = pk_bf16(bf_lo(o.x) * rstd * g0[0] * bf_lo(s.x), bf_hi(o.x) * rstd * g0[1] * bf_hi(s.x));
            w.y = pk_bf16(bf_lo(o.y) * rstd * g0[2] * bf_lo(s.y), bf_hi(o.y) * rstd * g0[3] * bf_hi(s.y));
            w.z = pk_bf16(bf_lo(o.z) * rstd * g1[0] * bf_lo(s.z), bf_hi(o.z) * rstd * g1[1] * bf_hi(s.z));
            w.w = pk_bf16(bf_lo(o.w) * rstd * g1[2] * bf_lo(s.w), bf_hi(o.w) * rstd * g1[3] * bf_hi(s.w));
            *op = w;
        }
    }
}

#define MFMA32(a, b, c) __builtin_amdgcn_mfma_f32_32x32x16_bf16((a), (b), (c), 0, 0, 0)
#define LDSV(T, off) (*(const LAS T*)(lds + (off)))

#define SB_() __builtin_amdgcn_sched_barrier(0)
template <int N>
__device__ __forceinline__ f32x16 chain_ab(LAS unsigned char* lds, int ao, int bo, f32x16 acc) {
    constexpr int D = 5;
    bf16x8 a[8], b[8];
#pragma unroll
    for (int s = 0; s < D && s < N; ++s) { a[s] = LDSV(bf16x8, ao + 32 * s); b[s] = LDSV(bf16x8, bo + 32 * s); }
    SB_();
#pragma unroll
    for (int s = 0; s < N; ++s) {
        if (s + D < N) { a[(s + D) & 7] = LDSV(bf16x8, ao + 32 * (s + D)); b[(s + D) & 7] = LDSV(bf16x8, bo + 32 * (s + D)); }
        SB_();
        acc = MFMA32(a[s & 7], b[s & 7], acc);
        SB_();
    }
    return acc;
}

__device__ __forceinline__ void gla_lowrank(LAS unsigned char* lds, const bf16_t* HB, const bf16_t* W16, const float* rowss, float* GLR, int vcu, int G, int wv) {
    const int wid = wv;
    for (int item = vcu; item < TH / 64; item += G) {
        const int lane = lane_op(), tid = wid * 64 + lane, l32 = lane & 31, hi = lane >> 5;
        constexpr int PP = 2064;
        __syncthreads();
        {
            const bf16_t* gp = HB + (size_t)item * 64 * DM;
            u32x4 t[16];
#pragma unroll
            for (int k = 0; k < 16; ++k) { const int p = tid + 512 * k; t[k] = *(const u32x4*)(gp + (size_t)(p >> 7) * DM + (p & 127) * 8); }
#pragma unroll
            for (int k = 0; k < 16; ++k) { const int p = tid + 512 * k; *(LAS u32x4*)(lds + (p >> 7) * PP + (p & 127) * 16) = t[k]; }
        }
        const bf16_t* gb = W16 + (size_t)l32 * DM + 128 * wid + 8 * hi;
        bf16x8 bq[8];
#pragma unroll
        for (int s = 0; s < 8; ++s) bq[s] = *(const bf16x8*)(gb + 16 * s);
        __syncthreads();
        const int ao = l32 * PP + (128 * wid + 8 * hi) * 2;
        f32x16 c0, c1;
#pragma unroll
        for (int r = 0; r < 16; ++r) { c0[r] = 0.f; c1[r] = 0.f; }
#pragma unroll
        for (int s = 0; s < 8; ++s) { c0 = MFMA32(LDSV(bf16x8, ao + 32 * s), bq[s], c0); c1 = MFMA32(LDSV(bf16x8, ao + 32 * PP + 32 * s), bq[s], c1); }
        __syncthreads();
#pragma unroll
        for (int r = 0; r < 16; ++r) { *(LAS float*)(lds + (((wid * 2 + 0) * 16 + r) * 64 + lane) * 4) = c0[r]; *(LAS float*)(lds + (((wid * 2 + 1) * 16 + r) * 64 + lane) * 4) = c1[r]; }
        __syncthreads();
        {
            const int pos = tid >> 3, g2 = (tid & 7) * 2, pb = pos >> 5, p5 = pos & 31, r = 4 * (p5 >> 3) + (p5 & 3), h2 = (p5 >> 2) & 1;
            float s0 = 0.f, s1 = 0.f;
#pragma unroll
            for (int w = 0; w < 8; ++w) { const f32x2 v = LDSV(f32x2, (((w * 2 + pb) * 16 + r) * 64 + h2 * 32 + g2) * 4); s0 += v[0]; s1 += v[1]; }
            const float rs = row_rstd(rowss, item * 64 + pos);
            *(f32x2*)(GLR + ((size_t)item * 64 + pos) * 16 + g2) = (f32x2){s0 * rs, s1 * rs};
        }
    }
    __syncthreads();
}

__device__ __forceinline__ void gla_prep(LAS unsigned char* lds, bf16_t* Q, const bf16_t* Kx, const float* GLR, const float* w2, const float* bgk, bf16_t* KD, bf16_t* SC, float* EB, int vcu, int G, int wv) {
    constexpr int QP = 528, OFF_QT = 0, OFF_KT = 64 * QP, OFF_TOT = 2 * 64 * QP, OFF_GL = OFF_TOT + 4096, OFF_END = OFF_GL + 4096;
    static_assert(OFF_END <= LDS_BYTES, "gla prep lds");
    const int wid = wv;
    for (int item = vcu; item < 16 * 64; item += G) {
        const int lane = lane_op(), l32 = lane & 31, hi = lane >> 5;
        const int qtr = wid >> 1, dp = (wid & 1) * 64 + lane, d0 = 2 * dp;
        const int bh = item >> 6, c = item & 63, b = bh >> 2, h = bh & 3;
        const size_t tok0 = (size_t)b * SEQ + (size_t)c * 64 + 16 * qtr;
        bf16_t* qg = Q + tok0 * DM + h * 256 + d0;
        const bf16_t* kg = Kx + tok0 * DM + h * 256 + d0;
        unsigned qr[16], kr[16];
#pragma unroll
        for (int i = 0; i < 16; ++i) { qr[i] = *(const unsigned*)(qg + (size_t)i * DM); kr[i] = *(const unsigned*)(kg + (size_t)i * DM); }
        float wa[16], wb[16];
#pragma unroll
        for (int r = 0; r < 16; ++r) { const f32x2 t = *(const f32x2*)(w2 + r * 1024 + h * 256 + d0); wa[r] = t[0]; wb[r] = t[1]; }
        const f32x2 bb = *(const f32x2*)(bgk + h * 256 + d0);
        __syncthreads();
        if (wid < 4) {
            const int t4 = wid * 64 + lane;
            *(LAS f32x4*)(lds + OFF_GL + t4 * 16) = *(const f32x4*)(GLR + ((size_t)b * SEQ + (size_t)c * 64) * 16 + t4 * 4);
        }
        __syncthreads();
        const int gl = OFF_GL + 16 * qtr * 64;
        float c0[16], c1[16]; float a0 = 0.f, a1 = 0.f;
#pragma unroll
        for (int i = 0; i < 16; ++i) {
            const f32x4 g0 = LDSV(f32x4, gl + i * 64), g1 = LDSV(f32x4, gl + i * 64 + 16), g2 = LDSV(f32x4, gl + i * 64 + 32), g3 = LDSV(f32x4, gl + i * 64 + 48);
            float x0 = bb[0], x1 = bb[1];
#pragma unroll
            for (int r = 0; r < 4; ++r) { x0 += g0[r] * wa[r]; x1 += g0[r] * wb[r]; }
#pragma unroll
            for (int r = 0; r < 4; ++r) { x0 += g1[r] * wa[4 + r]; x1 += g1[r] * wb[4 + r]; }
#pragma unroll
            for (int r = 0; r < 4; ++r) { x0 += g2[r] * wa[8 + r]; x1 += g2[r] * wb[8 + r]; }
#pragma unroll
            for (int r = 0; r < 4; ++r) { x0 += g3[r] * wa[12 + r]; x1 += g3[r] * wb[12 + r]; }
            a0 += (fminf(x0, 0.f) - __logf(1.f + fast_exp(-fabsf(x0)))) * 0.0625f;
            a1 += (fminf(x1, 0.f) - __logf(1.f + fast_exp(-fabsf(x1)))) * 0.0625f;
            c0[i] = a0; c1[i] = a1;
        }
        *(LAS f32x2*)(lds + OFF_TOT + (qtr * 256 + d0) * 4) = (f32x2){a0, a1};
        __syncthreads();
        const f32x2 t0 = LDSV(f32x2, OFF_TOT + (0 * 256 + d0) * 4), t1 = LDSV(f32x2, OFF_TOT + (1 * 256 + d0) * 4), t2 = LDSV(f32x2, OFF_TOT + (2 * 256 + d0) * 4), t3 = LDSV(f32x2, OFF_TOT + (3 * 256 + d0) * 4);
        const float of0 = (qtr > 0 ? t0[0] : 0.f) + (qtr > 1 ? t1[0] : 0.f) + (qtr > 2 ? t2[0] : 0.f);
        const float of1 = (qtr > 0 ? t0[1] : 0.f) + (qtr > 1 ? t1[1] : 0.f) + (qtr > 2 ? t2[1] : 0.f);
        const float bl0 = (t0[0] + t1[0]) + (t2[0] + t3[0]), bl1 = (t0[1] + t1[1]) + (t2[1] + t3[1]);
        const float ebl0 = fast_exp(bl0), ebl1 = fast_exp(bl1);
        unsigned kd0[8], kd1[8];
#pragma unroll
        for (int i = 0; i < 16; i += 2) {
            float kda[2], kdb[2];
#pragma unroll
            for (int e = 0; e < 2; ++e) {
                const int ii = i + e; const float b0 = of0 + c0[ii], b1 = of1 + c1[ii];
                const float q0 = bf_lo(qr[ii]), q1 = bf_hi(qr[ii]), k0 = bf_lo(kr[ii]), k1 = bf_hi(kr[ii]);
                const int pos = 16 * qtr + ii;
                const unsigned qt = pk_bf16(q0 * fast_exp(b0), q1 * fast_exp(b1));
                *(LAS unsigned*)(lds + OFF_QT + pos * QP + d0 * 2) = qt;
                *(unsigned*)(qg + (size_t)ii * DM) = qt;
                const float kn0 = k0 * fast_exp(-b0), kn1 = k1 * fast_exp(-b1);
                *(LAS unsigned*)(lds + OFF_KT + pos * QP + d0 * 2) = pk_bf16(kn0, kn1);
                kda[e] = kn0 * ebl0; kdb[e] = kn1 * ebl1;
            }
            kd0[i >> 1] = pk_bf16(kda[0], kda[1]); kd1[i >> 1] = pk_bf16(kdb[0], kdb[1]);
        }
        bf16_t* kdg = KD + ((size_t)item * 256 + d0) * 64 + 16 * qtr;
        *(u32x4*)(kdg) = (u32x4){kd0[0], kd0[1], kd0[2], kd0[3]};
        *(u32x4*)(kdg + 8) = (u32x4){kd0[4], kd0[5], kd0[6], kd0[7]};
        *(u32x4*)(kdg + 64) = (u32x4){kd1[0], kd1[1], kd1[2], kd1[3]};
        *(u32x4*)(kdg + 72) = (u32x4){kd1[4], kd1[5], kd1[6], kd1[7]};
        if (qtr == 0) *(f32x2*)(EB + (size_t)item * 256 + d0) = (f32x2){ebl0, ebl1};
        __syncthreads();
        if (wid < 3) {
            const int ib = wid > 0 ? 1 : 0, jb = wid > 1 ? 1 : 0;
            const int ao = OFF_KT + (32 * jb + l32) * QP + hi * 16, bo = OFF_QT + (32 * ib + l32) * QP + hi * 16;
            f32x16 acc;
#pragma unroll
            for (int r = 0; r < 16; ++r) acc[r] = 0.f;
            acc = chain_ab<16>(lds, ao, bo, acc);
            if (ib == jb) {
#pragma unroll
                for (int r = 0; r < 16; ++r) if (8 * (r >> 2) + 4 * hi + (r & 3) > l32) acc[r] = 0.f;
            }
            bf16_t* scg = SC + ((size_t)item * 64 + 32 * ib + l32) * 64 + 32 * jb + 4 * hi;
#pragma unroll
            for (int r4 = 0; r4 < 4; ++r4)
                *(u32x2*)(scg + 8 * r4) = (u32x2){pk_bf16(acc[4 * r4], acc[4 * r4 + 1]), pk_bf16(acc[4 * r4 + 2], acc[4 * r4 + 3])};
        }
    }
    __syncthreads();
}

__device__ __forceinline__ void gla_scan(LAS unsigned char* lds, const bf16_t* Q, const bf16_t* KD, const bf16_t* SC, const float* EB, const bf16_t* VO, bf16_t* OUT, float* HSS, int vcu, int G, int wv) {
    constexpr int QP = 528, KDP = 144, OFF_QT = 0, OFF_KD = 64 * QP, OFF_VT = OFF_KD + 256 * KDP, OFF_ST = OFF_VT + 32 * 144, OFF_SC = OFF_ST + 32 * QP,
                  OFF_EB = OFF_SC + 64 * 144, OFF_END = OFF_EB + 1024;
    static_assert(OFF_END <= LDS_BYTES, "gla lds");
    const int wid = wv;
    for (int item = vcu; item < 256; item += G) {
        const int lane = lane_op(), tid = wid * 64 + lane, l32 = lane & 31, hi = lane >> 5;
        const int bh = item >> 4, sl = item & 15, b = bh >> 2, h = bh & 3;
        const size_t tokb = (size_t)b * SEQ;
        const bf16_t* gq = Q + (tokb + (tid >> 5)) * DM + h * 256 + (tid & 31) * 8;
        const bf16_t* gkd = KD + ((size_t)bh * 64 * 256 + (tid >> 3)) * 64 + (tid & 7) * 8;
        const bf16_t* gsc = SC + ((size_t)bh * 64 * 64 + (tid >> 3)) * 64 + (tid & 7) * 8;
        const bf16_t* gv = VO + (tokb + ((tid & 255) >> 2)) * MIX + h * 512 + sl * 32 + (tid & 3) * 8;
        const float* geb = EB + (size_t)bh * 64 * 256 + (tid & 63) * 4;
        const int lq = OFF_QT + (tid >> 5) * QP + (tid & 31) * 16, lkd = OFF_KD + (tid >> 3) * KDP + (tid & 7) * 16, lsc = OFF_SC + (tid >> 3) * 144 + (tid & 7) * 16;
        __syncthreads();
        for (int i = tid; i < 32 * QP / 4; i += 512) *(LAS unsigned*)(lds + OFF_ST + 4 * i) = 0u;
        f32x16 S, S2;
#pragma unroll
        for (int r = 0; r < 16; ++r) { S[r] = 0.f; S2[r] = 0.f; }
        const int blk = wid, blk2 = wid - 2;
        u32x4 pq[2][4], pk[2][4], psc[2], pv[2];
        pv[0] = (u32x4){0u, 0u, 0u, 0u}; pv[1] = pv[0];
#pragma unroll
        for (int par = 0; par < 2; ++par) {
#pragma unroll
            for (int k = 0; k < 4; ++k) { pq[par][k] = *(const u32x4*)(gq + ((size_t)par * 64 + k * 16) * DM); pk[par][k] = *(const u32x4*)(gkd + ((size_t)par * 256 + k * 64) * 64); }
            psc[par] = *(const u32x4*)(gsc + (size_t)par * 64 * 64);
            if (tid < 256) pv[par] = *(const u32x4*)(gv + (size_t)par * 64 * MIX); else if (tid < 320) pv[par] = *(const u32x4*)(geb + (size_t)par * 256);
        }
        for (int c2 = 0; c2 < 64; c2 += 2) {
#pragma unroll
          for (int par = 0; par < 2; ++par) {
            const int c = c2 + par;
#pragma unroll
            for (int k = 0; k < 4; ++k) { *(LAS u32x4*)(lds + lq + k * 16 * QP) = pq[par][k]; *(LAS u32x4*)(lds + lkd + k * 64 * KDP) = pk[par][k]; }
            *(LAS u32x4*)(lds + lsc) = psc[par];
            if (tid < 256) {
                const int pos = tid >> 2, e0 = (tid & 3) * 8;
                LAS bf16_t* vt = (LAS bf16_t*)(lds + OFF_VT) + pos;
                const u32x4 v = pv[par];
                vt[(e0 + 0) * 72] = (bf16_t)(v.x & 0xffffu); vt[(e0 + 1) * 72] = (bf16_t)(v.x >> 16);
                vt[(e0 + 2) * 72] = (bf16_t)(v.y & 0xffffu); vt[(e0 + 3) * 72] = (bf16_t)(v.y >> 16);
                vt[(e0 + 4) * 72] = (bf16_t)(v.z & 0xffffu); vt[(e0 + 5) * 72] = (bf16_t)(v.z >> 16);
                vt[(e0 + 6) * 72] = (bf16_t)(v.w & 0xffffu); vt[(e0 + 7) * 72] = (bf16_t)(v.w >> 16);
            } else if (tid < 320) *(LAS u32x4*)(lds + OFF_EB + (tid & 63) * 16) = pv[par];
            if (c + 2 < 64) {
                const size_t cn = (size_t)(c + 2);
#pragma unroll
                for (int k = 0; k < 4; ++k) { pq[par][k] = *(const u32x4*)(gq + (cn * 64 + k * 16) * DM); pk[par][k] = *(const u32x4*)(gkd + (cn * 256 + k * 64) * 64); }
                psc[par] = *(const u32x4*)(gsc + cn * 64 * 64);
                if (tid < 256) pv[par] = *(const u32x4*)(gv + cn * 64 * MIX); else if (tid < 320) pv[par] = *(const u32x4*)(geb + cn * 256);
            }
            __syncthreads();
            f32x16 acc;
#pragma unroll
            for (int r = 0; r < 16; ++r) acc[r] = 0.f;
            if (wid < 2) {
                const int pb = wid;
                acc = chain_ab<16>(lds, OFF_ST + l32 * QP + hi * 16, OFF_QT + (32 * pb + l32) * QP + hi * 16, acc);
                const int ao = OFF_VT + l32 * 144 + hi * 16, bo = OFF_SC + (32 * pb + l32) * 144 + hi * 16;
                if (pb == 1) acc = chain_ab<4>(lds, ao, bo, acc); else acc = chain_ab<2>(lds, ao, bo, acc);
                const size_t tok = tokb + (size_t)c * 64 + 32 * pb + l32;
                bf16_t* orow = OUT + tok * MIX + h * 512 + sl * 32 + 4 * hi; float ss = 0.f;
#pragma unroll
                for (int r4 = 0; r4 < 4; ++r4) {
                    *(u32x2*)(orow + 8 * r4) = (u32x2){pk_bf16(acc[4 * r4], acc[4 * r4 + 1]), pk_bf16(acc[4 * r4 + 2], acc[4 * r4 + 3])};
                    ss += (acc[4 * r4] * acc[4 * r4] + acc[4 * r4 + 1] * acc[4 * r4 + 1]) + (acc[4 * r4 + 2] * acc[4 * r4 + 2] + acc[4 * r4 + 3] * acc[4 * r4 + 3]);
                }
                ss = x32_sum(ss);
                if (hi == 0) HSS[tok * 64 + h * 16 + sl] = ss;
            }
            if (wid >= 2) {
#pragma unroll
                for (int r4 = 0; r4 < 4; ++r4) { const f32x4 eb = LDSV(f32x4, OFF_EB + (32 * blk + 8 * r4 + 4 * hi) * 4);
                    S[4 * r4] *= eb[0]; S[4 * r4 + 1] *= eb[1]; S[4 * r4 + 2] *= eb[2]; S[4 * r4 + 3] *= eb[3]; }
                S = chain_ab<4>(lds, OFF_KD + (32 * blk + l32) * KDP + hi * 16, OFF_VT + l32 * 144 + hi * 16, S);
                if (wid < 4) {
#pragma unroll
                    for (int r4 = 0; r4 < 4; ++r4) { const f32x4 eb = LDSV(f32x4, OFF_EB + (32 * blk2 + 8 * r4 + 4 * hi) * 4);
                        S2[4 * r4] *= eb[0]; S2[4 * r4 + 1] *= eb[1]; S2[4 * r4 + 2] *= eb[2]; S2[4 * r4 + 3] *= eb[3]; }
                    S2 = chain_ab<4>(lds, OFF_KD + (32 * blk2 + l32) * KDP + hi * 16, OFF_VT + l32 * 144 + hi * 16, S2);
                }
            }
            __syncthreads();
            if (wid >= 2) {
#pragma unroll
                for (int r4 = 0; r4 < 4; ++r4)
                    *(LAS u32x2*)(lds + OFF_ST + l32 * QP + (32 * blk + 8 * r4 + 4 * hi) * 2) = (u32x2){pk_bf16(S[4 * r4], S[4 * r4 + 1]), pk_bf16(S[4 * r4 + 2], S[4 * r4 + 3])};
                if (wid < 4) {
#pragma unroll
                    for (int r4 = 0; r4 < 4; ++r4)
                        *(LAS u32x2*)(lds + OFF_ST + l32 * QP + (32 * blk2 + 8 * r4 + 4 * hi) * 2) = (u32x2){pk_bf16(S2[4 * r4], S2[4 * r4 + 1]), pk_bf16(S2[4 * r4 + 2], S2[4 * r4 + 3])};
                }
            }
          }
        }
    }
    __syncthreads();
}

__device__ __forceinline__ void attn_phase(LAS unsigned char* lds, const bf16_t* QO, bf16_t* OUT, const bf16_t* KK, const bf16_t* VT, const bf16_t* SG, const float* lam4, const float* gnorm, float lambda_init, int vcu, int G, int wv) {
    constexpr int KP = 272, VP = 80, OFF_V = 2 * 32 * KP, STG = OFF_V + 256 * VP, OFF_Q = 2 * STG;
    static_assert(OFF_Q + 8 * 32 * KP <= PTAB_OFF && 4 * 128 * 64 * 4 <= PTAB_OFF, "attn lds");
    const int wid = wv, j = wid >> 2, wq = wid & 3;
    float lam;
    { const int lane0 = lane_op();
      const float s01 = wave_sum(lam4[lane0] * lam4[128 + lane0] + lam4[64 + lane0] * lam4[192 + lane0]);
      const float s23 = wave_sum(lam4[256 + lane0] * lam4[384 + lane0] + lam4[320 + lane0] * lam4[448 + lane0]);
      lam = expf(s01) - expf(s23) + lambda_init; }
    for (int item = vcu; item < 256; item += G) {
        const int grp = item >> 5, w32 = item & 31, j16 = w32 & 15;
        for (int ui = 0; ui < 4; ++ui) {
            const int bh = grp * 4 + 2 * (ui >> 1) + (w32 >> 4), b = bh >> 3, h = bh & 7;
            const size_t tokb = (size_t)b * SEQ;
            const int qb = (ui & 1) ? j16 : 31 - j16;
            const int q0 = 128 * qb + 32 * wq, NT = 4 * (qb + 1), tdiag = 4 * qb + wq;
            const int lane = lane_op(), tid = wid * 64 + lane, l32 = lane & 31, hi = lane >> 5, c4 = tid & 3;
            const int lK = (tid >> 4) * KP + (tid & 15) * 16;
            const int lV = OFF_V + (tid >> 2) * VP + (16 * (c4 >> 1) + 4 * (c4 & 1)) * 2;
            {
                const bf16_t* qsrc = QO + (tokb + q0) * MIX + h * 256 + j * 128;
#pragma unroll
                for (int i = 0; i < 8; ++i) { const int p = lane + 64 * i, row = p >> 4, c16 = p & 15;
                    *(LAS u32x4*)(lds + OFF_Q + wid * (32 * KP) + row * KP + c16 * 16) = *(const u32x4*)(qsrc + (size_t)row * MIX + c16 * 8); }
            }
            const int qo = OFF_Q + wid * (32 * KP) + l32 * KP + hi * 16;
            f32x16 o[8];
#pragma unroll
            for (int db = 0; db < 8; ++db)
#pragma unroll
                for (int r = 0; r < 16; ++r) o[db][r] = 0.f;
            float mrun = 0.f, lsum = 0.f;
            const bf16_t* gK1 = KK + (tokb + (tid >> 4)) * MIX + h * 256 + (tid & 15) * 8;
            const bf16_t* gV1 = VT + (((size_t)(b * 8 + h) * 128) * 256 + (tid >> 2)) * 32 + c4 * 8;
            u32x4 ra0, ra1, ra2, ra3;
            f32x16 negm;
#pragma unroll
            for (int r = 0; r < 16; ++r) negm[r] = 0.f;
#define ATT_LOAD(R, tt) do { const bf16_t* k1_ = gK1 + (size_t)(tt) * 32 * MIX; const bf16_t* v1_ = gV1 + (size_t)(tt) * 8192; \
                R##0 = *(const u32x4*)k1_; R##1 = *(const u32x4*)(k1_ + 128); R##2 = *(const u32x4*)v1_; R##3 = *(const u32x4*)(v1_ + 4096); } while (0)
#define ATT_WRITE(R, base) do { const u32x4 w2_ = R##2, w3_ = R##3; \
                *(LAS u32x4*)(lds + (base) + lK) = R##0; *(LAS u32x4*)(lds + (base) + 32 * KP + lK) = R##1; \
                *(LAS u32x2*)(lds + (base) + lV) = (u32x2){w2_.x, w2_.y}; *(LAS u32x2*)(lds + (base) + lV + 16) = (u32x2){w2_.z, w2_.w}; \
                *(LAS u32x2*)(lds + (base) + lV + 128 * VP) = (u32x2){w3_.x, w3_.y}; *(LAS u32x2*)(lds + (base) + lV + 128 * VP + 16) = (u32x2){w3_.z, w3_.w}; } while (0)
#define ATT_TILE(cur, t) do { if ((t) <= tdiag) { \
                const int ko = (cur) + j * 32 * KP + l32 * KP + hi * 16, vo = (cur) + OFF_V + l32 * VP + hi * 16; \
                f32x16 sT; \
                bf16x8 vf[4]; \
                { bf16x8 kf[4], qq[4]; \
                  _Pragma("unroll") for (int s = 0; s < 3; ++s) { kf[s] = LDSV(bf16x8, ko + 32 * s); qq[s] = LDSV(bf16x8, qo + 32 * s); } \
                  SB_(); \
                  _Pragma("unroll") for (int s = 0; s < 8; ++s) { \
                      if (s + 3 < 8) { kf[(s + 3) & 3] = LDSV(bf16x8, ko + 32 * (s + 3)); qq[(s + 3) & 3] = LDSV(bf16x8, qo + 32 * (s + 3)); } \
                      SB_(); sT = MFMA32(kf[s & 3], qq[s & 3], s == 0 ? negm : sT); SB_(); } } \
                _Pragma("unroll") for (int i = 0; i < 3; ++i) vf[i] = LDSV(bf16x8, vo + (i >> 1) * 32 * VP + (i & 1) * 32); \
                SB_(); \
                if ((t) == tdiag) { _Pragma("unroll") for (int r = 0; r < 16; ++r) if (8 * (r >> 2) + 4 * hi + (r & 3) > l32) sT[r] = -1e30f; } \
                float mx = sT[0]; \
                _Pragma("unroll") for (int r = 1; r < 16; ++r) mx = fmaxf(mx, sT[r]); \
                mx = x32_max(mx); \
                if ((t) == 0 || __any(mx > 8.f)) {         \
                    const float dl = ((t) == 0 || mx > 8.f) ? mx : 0.f, alpha = __builtin_amdgcn_exp2f(-dl); \
                    mrun += dl; lsum *= alpha; \
                    _Pragma("unroll") for (int r = 0; r < 16; ++r) { sT[r] -= dl; negm[r] = -mrun; } \
                    _Pragma("unroll") for (int db = 0; db < 8; ++db) _Pragma("unroll") for (int r = 0; r < 16; ++r) o[db][r] *= alpha; } \
                float ps = 0.f; \
                _Pragma("unroll") for (int r = 0; r < 16; ++r) { sT[r] = __builtin_amdgcn_exp2f(sT[r]); ps += sT[r]; } \
                lsum += ps; \
                const u32x4 p0 = {pk_bf16(sT[0], sT[1]), pk_bf16(sT[2], sT[3]), pk_bf16(sT[4], sT[5]), pk_bf16(sT[6], sT[7])}; \
                const u32x4 p1 = {pk_bf16(sT[8], sT[9]), pk_bf16(sT[10], sT[11]), pk_bf16(sT[12], sT[13]), pk_bf16(sT[14], sT[15])}; \
                const bf16x8 pb0 = __builtin_bit_cast(bf16x8, p0), pb1 = __builtin_bit_cast(bf16x8, p1); \
                SB_(); \
                _Pragma("unroll") for (int i = 0; i < 16; ++i) { \
                    if (i + 3 < 16) vf[(i + 3) & 3] = LDSV(bf16x8, vo + ((i + 3) >> 1) * 32 * VP + ((i + 3) & 1) * 32); \
                    SB_(); o[i >> 1] = MFMA32(vf[i & 3], (i & 1) ? pb1 : pb0, o[i >> 1]); SB_(); } } } while (0)
            ATT_LOAD(ra, 0);
            ATT_WRITE(ra, 0);
            __syncthreads();
            for (int t = 0; t < NT; t += 2) {
                ATT_LOAD(ra, t + 1);
                ATT_TILE(0, t);
                ATT_WRITE(ra, STG);
                __syncthreads();
                if (t + 2 < NT) ATT_LOAD(ra, t + 2);
                ATT_TILE(STG, t + 1);
                if (t + 2 < NT) ATT_WRITE(ra, 0);
                __syncthreads();
            }
#undef ATT_LOAD
#undef ATT_TILE
#undef ATT_WRITE
            const float l = x32_sum(lsum), inv = 1.f / l;
            const int lane_e = lane_op(), l32e = lane_e & 31, hie = lane_e >> 5;
            const int xo = (wq * 128 * 64 + lane_e) * 4;
            if (j == 1) {
                const float f = lam * inv;
#pragma unroll
                for (int db = 0; db < 8; ++db)
#pragma unroll
                    for (int r = 0; r < 16; ++r) *(LAS float*)(lds + xo + (db * 16 + r) * 256) = o[db][r] * f;
            }
            __syncthreads();
            if (j == 0) {
                float ss = 0.f;
#pragma unroll
                for (int db = 0; db < 8; ++db) {
#pragma unroll
                    for (int r = 0; r < 16; ++r) { const float v = o[db][r] * inv - LDSV(float, xo + (db * 16 + r) * 256); o[db][r] = v; ss += v * v; }
                    asm volatile("" : "+v"(o[db]), "+v"(ss) :: "memory");
                }
                ss = x32_sum(ss);
                const float rstd = __builtin_amdgcn_rsqf(ss * (1.f / 256.f) + EPS) * (1.f - lambda_init);
                bf16_t* orow = OUT + (tokb + q0 + l32e) * MIX + h * 256 + 4 * hie; const bf16_t* grow = SG + (tokb + q0 + l32e) * MIX + h * 256 + 4 * hie;
#pragma unroll
                for (int db = 0; db < 8; ++db)
#pragma unroll
                    for (int r4 = 0; r4 < 4; ++r4) {
                        const int dv = 32 * db + 8 * r4;
                        const f32x4 g = *(const f32x4*)(gnorm + dv + 4 * hie); const u32x2 sg = *(const u32x2*)(grow + dv);
                        u32x2 w;
                        w.x = pk_bf16(o[db][4 * r4] * rstd * g[0] * bf_lo(sg.x), o[db][4 * r4 + 1] * rstd * g[1] * bf_hi(sg.x));
                        w.y = pk_bf16(o[db][4 * r4 + 2] * rstd * g[2] * bf_lo(sg.y), o[db][4 * r4 + 3] * rstd * g[3] * bf_hi(sg.y));
                        *(u32x2*)(orow + dv) = w;
                        if (r4 & 1) asm volatile("" ::: "memory");
                    }
            }
            __syncthreads();
        }
    }
}

#define XB_TMO      128
#define XB_XCNT(j)  (256  + 64 * (j))
#define XB_XSUB(j)  (1280 + 64 * (j))
#define XB_XGEN(j)  (2304 + 64 * (j))
#define XB_TOP      3328
#define XB_TOPGEN   3392
#define XCD_BAR_WORDS 3456
#define XB_SPIN_CAP (1u << 18)

__device__ __forceinline__ unsigned xb_ld(unsigned* p)              { return __hip_atomic_load(p, __ATOMIC_RELAXED, __HIP_MEMORY_SCOPE_AGENT); }
__device__ __forceinline__ unsigned xb_add(unsigned* p, unsigned v) { return __hip_atomic_fetch_add(p, v, __ATOMIC_RELAXED, __HIP_MEMORY_SCOPE_AGENT); }
__device__ __forceinline__ unsigned xb_xcc_id() { return (unsigned)__builtin_amdgcn_s_getreg((3 << 11) | 20) & 0xFu; }
#define XB_SPIN(cond, bar) do { unsigned _sp = 0; while (cond) { __builtin_amdgcn_s_sleep(1); \
    if ((++_sp & 255u) == 0u) { if (xb_ld(&(bar)[XB_TMO])) break; if (_sp > XB_SPIN_CAP) { atomicAdd(&(bar)[XB_TMO], 1u); break; } } } } while (0)

struct XcdBarrier {
    unsigned* bar; unsigned x;
    volatile LAS unsigned* st;
};

__device__ __forceinline__ XcdBarrier xcd_barrier_post(unsigned* bar, volatile LAS unsigned* st, bool t0) {
    XcdBarrier b; b.bar = bar; b.x = xb_xcc_id(); b.st = st;
    if (t0) (void)xb_add(&bar[XB_XCNT(b.x)], 1u);
    return b;
}
__device__ __forceinline__ void xcd_barrier_complete(unsigned* bar, unsigned x, unsigned& nloc, unsigned& nx) {
    const unsigned G = gridDim.x * gridDim.y * gridDim.z;
    unsigned sum, cnt, mine, sp = 0u;
    for (;;) {
        sum = 0u; cnt = 0u; mine = 0u;
#pragma unroll
        for (unsigned j = 0; j < 16; ++j) { const unsigned c = xb_ld(&bar[XB_XCNT(j)]); sum += c; cnt += (c > 0u) ? 1u : 0u; mine = (j == x) ? c : mine; }
        if (sum == G) break;
        __builtin_amdgcn_s_sleep(1);
        if ((++sp & 255u) == 0u) { if (xb_ld(&bar[XB_TMO])) break; if (sp > XB_SPIN_CAP) { atomicAdd(&bar[XB_TMO], 1u); break; } }
    }
    nloc = mine > 0u ? mine : 1u; nx = cnt > 0u ? cnt : 1u;
}

__device__ __forceinline__ void xcd_barrier(const XcdBarrier& b, bool t0) {
    asm volatile("s_waitcnt vmcnt(0)" ::: "memory");
    __syncthreads();
    if (t0) {
        unsigned* bar = b.bar;
        __builtin_amdgcn_s_waitcnt(0);
        unsigned nloc = b.st[0], nx = b.st[1];
        if (nloc == 0u) { xcd_barrier_complete(bar, b.x, nloc, nx); b.st[0] = nloc; b.st[1] = nx; }
        const unsigned old = xb_add(&bar[XB_XSUB(b.x)], 1u);
        const unsigned gen = old / nloc;
        if (old + 1u == (gen + 1u) * nloc) {
            __builtin_amdgcn_fence(__ATOMIC_RELEASE, "agent");
            asm volatile("s_waitcnt vmcnt(0)" ::: "memory");
            const unsigned og = xb_add(&bar[XB_TOP], 1u);
            const unsigned tg = og / nx;
            if (og + 1u == (tg + 1u) * nx) xb_add(&bar[XB_TOPGEN], 1u);
            else XB_SPIN(xb_ld(&bar[XB_TOPGEN]) == tg, bar);
            __builtin_amdgcn_fence(__ATOMIC_ACQUIRE, "agent");
            xb_add(&bar[XB_XGEN(b.x)], 1u);
            asm volatile("s_waitcnt vmcnt(0)" ::: "memory");
        } else {
            XB_SPIN(xb_ld(&bar[XB_XGEN(b.x)]) == gen, bar);
            __builtin_amdgcn_fence(__ATOMIC_ACQUIRE, "agent");
            asm volatile("s_waitcnt vmcnt(0)" ::: "memory");
        }
    }
    __syncthreads();
}

__device__ __forceinline__ unsigned long long ptab_get(LAS unsigned char*, int k) {
    const __attribute__((address_space(4))) unsigned long long* kp = (const __attribute__((address_space(4))) unsigned long long*)__builtin_amdgcn_kernarg_segment_ptr();
    asm volatile("" : "+s"(kp));
    return kp[k];
}
__global__ void __launch_bounds__(512) yoco_fwd(Params a) {
    extern __shared__ __attribute__((aligned(16))) unsigned char lds_raw[];
    LAS unsigned char* lds = (LAS unsigned char*)lds_raw;
    cg::grid_group grid = cg::this_grid();
    const int G = (int)gridDim.x, bx = (int)blockIdx.x;
    if (threadIdx.x < 64) ((LAS unsigned*)(lds + LDS_BYTES - 256))[threadIdx.x] = 0u;
    __syncthreads();
    const int wv = __builtin_amdgcn_readfirstlane((int)threadIdx.x >> 6);
#define tid (wv * 64 + lane_op())
#define run_gemm(...) run_gemm_(wv, __VA_ARGS__)
    const int vcu = (G % 8 == 0) ? (bx % 8) * (G / 8) + bx / 8 : bx;
#define PTR(T, k) ((T*)(__attribute__((address_space(1))) T*)ptab_get(lds, (k)))
#define WSP(T, off) ((T*)(__attribute__((address_space(1))) T*)(ptab_get(lds, 19) + (off)))
#define HBB WSP(bf16_t, WS_HBB)
#define HBA WSP(bf16_t, WS_HBA)
#define RSB WSP(float, WS_RSB)
#define RSA WSP(float, WS_RSA)
#define PBF WSP(bf16_t, WS_PBF)
#define GBUF WSP(bf16_t, WS_GBUF)
#define HSS WSP(float, WS_HSS)
#define R0 WSP(bf16_t, WS_R0)
#define R1 WSP(bf16_t, WS_R1)
#define R2 WSP(bf16_t, WS_R2)
#define R3 WSP(bf16_t, WS_R3)
#define R4 WSP(bf16_t, WS_R4)
#define ws ((unsigned char*)(__attribute__((address_space(1))) unsigned char*)ptab_get(lds, 19))
    const XcdBarrier bar = xcd_barrier_post((unsigned*)ws, (volatile LAS unsigned*)(lds + LDS_BYTES - 256), tid == 0);
#define GSYNC() xcd_barrier(bar, tid == 0)
    prologue_weights(a, lds, tid);
#pragma unroll 1
    for (int half = 0; half < 2; ++half) {
        const size_t tok0 = (size_t)half * TH;
#define H (PTR(float, 18) + tok0 * DM)
        init_rows(PTR(const float, 0) + tok0 * DM, HBB, RSB, tid);
        if (half == 0) grid.sync(); else GSYNC();
#pragma unroll 1
        for (int i = 0; i < 4; ++i) {
            if (i < 2) {
                gla_lowrank(lds, HBB, (const bf16_t*)(ws + WS_WGLAIN) + (size_t)i * GLA_N * DM + (size_t)6144 * DM, RSB, HSS, vcu, G, wv);
                { EpiGlaIn E{RSB, R0, R1, R2, R3};
                  run_gemm(lds, HBB, (const bf16_t*)(ws + WS_WGLAIN) + (size_t)i * GLA_N * DM, TH, 6144, DM, E); }
                GSYNC();
                gla_prep(lds, R0, R1, HSS, PTR(const float, 4) + i * 16 * 1024, PTR(const float, 5) + i * 1024, GBUF, HBA, RSA, vcu, G, wv);
                GSYNC();
                gla_scan(lds, R0, GBUF, HBA, RSA, R2, R2, HSS, vcu, G, wv);
                GSYNC();
                gla_norm_gate(R2, R3, HSS, PTR(const float, 6) + i * 512, tid);
                convert_p(PTR(const float, 1) + ((size_t)i * NB * SEQ + tok0) * PLE, PBF, tid);
                GSYNC();
                { EpiResid<false> E{i == 0 ? PTR(const float, 0) + tok0 * DM : (const float*)H, H, HBA, RSA, nullptr};
                  run_gemm(lds, R2, (const bf16_t*)(ws + WS_WGLAOUT) + (size_t)i * DM * MIX, TH, DM, MIX, E); }
                GSYNC();
            } else {
                const int jl = i - 2;
                if (jl == 0) {
                    { EpiProj2<0> E{RSB, R0, R0, 8, 1.f};
                      run_gemm(lds, HBB, (const bf16_t*)(ws + WS_WKV), TH, MIX, DM, E); }
                    { EpiVT E{RSB, R2};
                      run_gemm(lds, (const bf16_t*)(ws + WS_WKV) + (size_t)MIX * DM, HBB, MIX, TH, DM, E); }
                }
                convert_p(PTR(const float, 1) + ((size_t)i * NB * SEQ + tok0) * PLE, PBF, tid);
                { EpiProj2<1> E{RSB, R3, R4, 8, 0.08838834764831845f * 1.4426950408889634f};
                  run_gemm(lds, HBB, (const bf16_t*)(ws + WS_WDIN) + (size_t)jl * 4096 * DM, TH, 4096, DM, E); }
                GSYNC();
                const float lambda_init = 0.8f - 0.6f * expf(-0.3f * (float)i);
                attn_phase(lds, R3, R3, R0, R2, R4, PTR(const float, 11) + jl * 512, PTR(const float, 12) + jl * 256, lambda_init, vcu, G, wv);
                GSYNC();
                { EpiResid<false> E{H, H, HBA, RSA, nullptr};
                  run_gemm(lds, R3, (const bf16_t*)(ws + WS_WDOUT) + (size_t)jl * DM * MIX, TH, DM, MIX, E); }
                GSYNC();
            }
            { EpiGate E{RSA, GBUF};
              run_gemm(lds, HBA, (const bf16_t*)(ws + WS_WPG) + (size_t)i * DM * DM, TH, DM, DM, E); }
            { EpiResid<true> E{H, H, HBB, RSB, GBUF};
              run_gemm(lds, PBF, (const bf16_t*)(ws + WS_WPP) + (size_t)i * DM * PLE, TH, DM, PLE, E); }
            GSYNC();
        }
        final_rows(H, PTR(const float, 17), tid);
    }
}

#undef tid
#undef GSYNC
#undef run_gemm
#undef ws
#undef H
#undef HBB
#undef HBA
#undef RSB
#undef RSA
#undef PBF
#undef GBUF
#undef HSS
#undef R0
#undef R1
#undef R2
#undef R3
#undef R4
#undef PTR
#undef WSP
extern "C" void kernel_launch(void* const* d_in, const int* in_sizes, int n_in, void* d_out, int out_size, void* d_ws, size_t ws_size, hipStream_t stream) {
    static int grid = 0;
    if (grid == 0) {
        if (n_in != 18 || ws_size < WS_END) { fprintf(stderr, "kernel_launch: unexpected inputs (n_in %d, ws %zu)\n", n_in, ws_size); grid = -1; return; }
        int dev = 0, cus = 0, per_cu = 0;
        hipGetDevice(&dev);
        hipDeviceGetAttribute(&cus, hipDeviceAttributeMultiprocessorCount, dev);
        if (hipFuncSetAttribute((const void*)yoco_fwd, hipFuncAttributeMaxDynamicSharedMemorySize, LDS_BYTES) != hipSuccess) { fprintf(stderr, "hipFuncSetAttribute failed\n"); grid = -1; return; }
        if (hipOccupancyMaxActiveBlocksPerMultiprocessor(&per_cu, (const void*)yoco_fwd, 512, LDS_BYTES) != hipSuccess || per_cu < 1) per_cu = 1;
        (void)hipGetLastError();
        grid = cus * per_cu;
    }
    if (grid < 0) return;
    if (hipMemsetAsync(d_ws, 0, 65536, stream) != hipSuccess) { fprintf(stderr, "memset of barrier words failed\n"); return; }
    Params p{};
    p.x = (const float*)d_in[0]; p.p = (const float*)d_in[1]; p.norm_mix = (const float*)d_in[2]; p.gla_w_in = (const float*)d_in[3]; p.gla_w_gk2 = (const float*)d_in[4];
    p.gla_b_gk = (const float*)d_in[5]; p.gla_norm = (const float*)d_in[6]; p.gla_w_out = (const float*)d_in[7]; p.kv_norm = (const float*)d_in[8]; p.w_kv = (const float*)d_in[9];
    p.diff_w_in = (const float*)d_in[10]; p.diff_lambda = (const float*)d_in[11]; p.diff_norm = (const float*)d_in[12]; p.diff_w_out = (const float*)d_in[13];
    p.ple_norm = (const float*)d_in[14]; p.ple_w_gate = (const float*)d_in[15]; p.ple_w_proj = (const float*)d_in[16]; p.final_norm = (const float*)d_in[17];
    p.out = (float*)d_out; p.ws = (unsigned char*)d_ws;
    void* args[] = {&p};
    hipError_t e = hipLaunchCooperativeKernel((const void*)yoco_fwd, dim3(grid), dim3(512), args, LDS_BYTES, stream);
    if (e != hipSuccess) fprintf(stderr, "cooperative launch failed: %s (grid %d)\n", hipGetErrorString(e), grid);
}
```

```cpp
#include <hip/hip_runtime.h>
#include <hip/hip_cooperative_groups.h>
#include <cstdio>
#include <cstdint>
namespace cg = cooperative_groups;
namespace pg8 {
#define PG8_LAS __attribute__((address_space(3)))
typedef unsigned short bf16_t;
typedef short bf16x8 __attribute__((ext_vector_type(8)));
typedef float f32x4 __attribute__((ext_vector_type(4)));
typedef unsigned u32x4 __attribute__((ext_vector_type(4)));
constexpr int BM = 256, BK = 64, HALF = 128, HTB = HALF * BK * 2  , STAGE_BYTES = 8 * HTB, NXCD = 8, WGM = 4;

__host__ __device__ __forceinline__ int lds_byte(int r, int c) { const int st = (r >> 4) * 2 + (c >> 5), rr = r & 15, cc = c & 31, ob = rr * 64 + cc * 2; return st * 1024 + (ob ^ (((ob >> 9) & 1) << 5)); }
__host__ __device__ __forceinline__ void stage_rc(int b, int& R, int& C) { const int st = b / 1024, sb = b % 1024, swz = sb ^ (((sb >> 9) & 1) << 5); R = (st >> 1) * 16 + swz / 64; C = (st & 1) * 32 + (swz % 64) / 2; }
__host__ __device__ __forceinline__ int perm32(int rho) { const int n = rho >> 4, i = rho & 15; return 8 * (i >> 2) + 4 * n + (i & 3); }

struct Unit { int pm, pn; };
struct Gemm { const bf16_t* A; const bf16_t* Bt; int M, N, K; };

struct StaticOrder {
    int nM, nN, nwg, G, c;
    __host__ __device__ void init(int M, int N, int G_, int c_) { nM = M / BM; nN = N / BM; nwg = nM * nN; G = G_; c = c_; }
    __host__ __device__ bool next(int i, Unit& u) const {
        const long L = (long)i * G + c; if (L >= nwg) return false;
        int wgid = (int)L; { const int q = nwg / NXCD, r = nwg % NXCD, xcd = wgid % NXCD, off = wgid / NXCD; wgid = (xcd < r ? xcd * (q + 1) : r * (q + 1) + (xcd - r) * q) + off; }
        const int nig = WGM * nN, gid = wgid / nig, fm = gid * WGM, gsz = (nM - fm) < WGM ? (nM - fm) : WGM;
        u.pm = fm + ((wgid % nig) % gsz); u.pn = (wgid % nig) / gsz; return true;
    }
    __device__ __forceinline__ void a_ready(const Unit&) const {}
    __device__ __forceinline__ void done(const Unit&) const {}
};

template <class Epi, class Sched, bool ALIGN_EPI = false, bool SP2 = false>
__device__ __forceinline__ void gemm_phase(PG8_LAS unsigned char* lds, const Gemm g, const Sched& S, const Epi& E, int wv) {
    int tid_; { int l_; asm volatile("v_mbcnt_lo_u32_b32 %0, -1, 0\n\tv_mbcnt_hi_u32_b32 %0, -1, %0" : "=v"(l_)); tid_ = wv * 64 + l_; }
    const int tid = tid_, wid = __builtin_amdgcn_readfirstlane(tid >> 6), lane = tid & 63, wr = wid >> 2, wc = wid & 3, fr = lane & 15, fq = lane >> 4;
    const int K = g.K, nt = K / BK;
    unsigned voffA[2], voffB[2];
#pragma unroll
    for (int i = 0; i < 2; ++i) { int R, C; stage_rc(tid * 16 + i * 8192, R, C); const int Rb = Epi::PERM ? ((R & ~31) + perm32(R & 31)) : R;
        voffA[i] = (unsigned)(R * K + C) * 2u; voffB[i] = (unsigned)(Rb * K + C) * 2u; }
    const size_t kstep = (size_t)(BK * 2);
    const size_t hstep = (size_t)HALF * K * 2;
    const size_t tstep = 2 * hstep;
    const unsigned ldsw = (unsigned)wid * 1024u;
    const int aoff = lds_byte(wr * 64 + fr, fq * 8), boff = lds_byte(wc * 32 + fr, fq * 8);
#define PG8_SA(b, h) (((b) * 2 + (h)) * HTB)
#define PG8_SB(b, h) ((4 + (b) * 2 + (h)) * HTB)
#define PG8_STAGE(bufoff, gbase, voff) do { _Pragma("unroll") for (int _i = 0; _i < 2; ++_i) \
        __builtin_amdgcn_global_load_lds((const unsigned*)((const char*)(gbase) + (voff)[_i]), (PG8_LAS unsigned*)(lds + (bufoff) + ldsw + _i * 8192), 16, 0, 0); } while (0)
#define PG8_LDA(dst, b, h) do { _Pragma("unroll") for (int m = 0; m < 4; ++m) _Pragma("unroll") for (int k = 0; k < 2; ++k) dst[m][k] = *(const PG8_LAS bf16x8*)(lds + PG8_SA(b, h) + aoff + m * 2048 + k * 1024); } while (0)
#define PG8_LDB(dst, b, h) do { _Pragma("unroll") for (int n = 0; n < 2; ++n) _Pragma("unroll") for (int k = 0; k < 2; ++k) dst[n][k] = *(const PG8_LAS bf16x8*)(lds + PG8_SB(b, h) + boff + n * 2048 + k * 1024); } while (0)
#define PG8_MMA(ai, bj, At, Bt) do { __builtin_amdgcn_s_setprio(1); _Pragma("unroll") for (int m = 0; m < 4; ++m) _Pragma("unroll") for (int n = 0; n < 2; ++n) _Pragma("unroll") for (int k = 0; k < 2; ++k) \
        acc[ai][bj][m][n] = __builtin_amdgcn_mfma_f32_16x16x32_bf16(Bt[n][k], At[m][k], acc[ai][bj][m][n], 0, 0, 0); __builtin_amdgcn_s_setprio(0); } while (0)
#define PG8_WAIT_V(n) asm volatile("s_waitcnt vmcnt(" #n ")" ::: "memory")
#define PG8_WAIT_L(n) asm volatile("s_waitcnt lgkmcnt(" #n ")" ::: "memory")
#define PG8_BAR __builtin_amdgcn_s_barrier()
#define PG8_SCHED __builtin_amdgcn_sched_barrier(0)
    Unit cur, nxt; int ui = 0;
    if (!S.next(0, cur)) return;
    f32x4 acc[2][2][4][2];
#pragma unroll
    for (int a = 0; a < 2; ++a)
#pragma unroll
        for (int b = 0; b < 2; ++b)
#pragma unroll
            for (int m = 0; m < 4; ++m)
#pragma unroll
                for (int n = 0; n < 2; ++n) acc[a][b][m][n] = (f32x4){0.f, 0.f, 0.f, 0.f};
    bf16x8 At[4][2], B0[2][2], B1[2][2];
    const char* cA = (const char*)g.A + (size_t)cur.pm * tstep; const char* cB = (const char*)g.Bt + (size_t)cur.pn * tstep;
    S.a_ready(cur);
    if constexpr (SP2) {
        PG8_STAGE(PG8_SB(0, 0), cB, voffB); PG8_STAGE(PG8_SB(0, 1), cB + hstep, voffB); PG8_STAGE(PG8_SA(0, 0), cA, voffA); PG8_STAGE(PG8_SA(0, 1), cA + hstep, voffA);
        if (wr == 1) PG8_BAR;
        PG8_WAIT_V(2); PG8_BAR;
        PG8_STAGE(PG8_SB(1, 0), cB + kstep, voffB); PG8_STAGE(PG8_SA(1, 0), cA + kstep, voffA); PG8_STAGE(PG8_SB(1, 1), cB + hstep + kstep, voffB);
        PG8_WAIT_V(6); PG8_BAR;
    } else {
        PG8_STAGE(PG8_SB(0, 0), cB, voffB); PG8_STAGE(PG8_SA(0, 0), cA, voffA); PG8_STAGE(PG8_SB(0, 1), cB + hstep, voffB); PG8_STAGE(PG8_SA(0, 1), cA + hstep, voffA);
        if (wr == 1) PG8_BAR;
        PG8_WAIT_V(4); PG8_BAR;
        PG8_STAGE(PG8_SB(1, 0), cB + kstep, voffB); PG8_STAGE(PG8_SA(1, 0), cA + kstep, voffA); PG8_STAGE(PG8_SB(1, 1), cB + hstep + kstep, voffB);
        PG8_WAIT_V(6); PG8_BAR;
    }
    for (;;) {
        const bool has_next = S.next(ui + 1, nxt);
        const char* nA = has_next ? (const char*)g.A + (size_t)nxt.pm * tstep : cA; const char* nB = has_next ? (const char*)g.Bt + (size_t)nxt.pn * tstep : cB;
        for (int t = 0; t < nt; t += 2) {
            const bool last = (t == nt - 2);
            const char* a1 = cA + (size_t)(t + 1) * kstep;
            const char* a2 = last ? nA : cA + (size_t)(t + 2) * kstep; const char* b2 = last ? nB : cB + (size_t)(t + 2) * kstep;
            const char* a3 = a2 + kstep; const char* b3 = b2 + kstep;
            if (last && has_next) S.a_ready(nxt);
            if constexpr (SP2) {
            PG8_LDB(B0, 0, 0); PG8_LDB(B1, 0, 1); PG8_SCHED; PG8_LDA(At, 0, 0); PG8_STAGE(PG8_SA(1, 1), a1 + hstep, voffA);
            PG8_WAIT_V(8); PG8_WAIT_L(0); PG8_BAR; PG8_MMA(0, 0, At, B0); PG8_MMA(0, 1, At, B1); PG8_BAR; PG8_SCHED;
            PG8_LDA(At, 0, 1); PG8_STAGE(PG8_SB(0, 0), b2, voffB); PG8_STAGE(PG8_SB(0, 1), b2 + hstep, voffB); PG8_STAGE(PG8_SA(0, 0), a2, voffA);
            PG8_WAIT_V(8); PG8_WAIT_L(0); PG8_BAR; PG8_MMA(1, 0, At, B0); PG8_MMA(1, 1, At, B1); PG8_BAR; PG8_SCHED;
            PG8_LDB(B0, 1, 0); PG8_LDB(B1, 1, 1); PG8_SCHED; PG8_LDA(At, 1, 0); PG8_STAGE(PG8_SA(0, 1), a2 + hstep, voffA);
            PG8_WAIT_V(8); PG8_WAIT_L(0); PG8_BAR; PG8_MMA(0, 0, At, B0); PG8_MMA(0, 1, At, B1); PG8_BAR; PG8_SCHED;
            PG8_LDA(At, 1, 1); PG8_STAGE(PG8_SB(1, 0), b3, voffB); PG8_STAGE(PG8_SB(1, 1), b3 + hstep, voffB); PG8_STAGE(PG8_SA(1, 0), a3, voffA);
            PG8_WAIT_V(8); PG8_WAIT_L(0); PG8_BAR; PG8_MMA(1, 0, At, B0); PG8_MMA(1, 1, At, B1); PG8_BAR; PG8_SCHED;
            } else {
            PG8_LDB(B0, 0, 0); PG8_SCHED; PG8_LDA(At, 0, 0); PG8_STAGE(PG8_SA(1, 1), a1 + hstep, voffA);
            PG8_WAIT_L(8); PG8_BAR; PG8_WAIT_L(0); PG8_MMA(0, 0, At, B0); PG8_BAR; PG8_SCHED;
            PG8_LDB(B1, 0, 1); PG8_STAGE(PG8_SB(0, 0), b2, voffB);
            PG8_BAR; PG8_WAIT_L(0); PG8_MMA(0, 1, At, B1); PG8_BAR;
            PG8_LDA(At, 0, 1); PG8_STAGE(PG8_SA(0, 0), a2, voffA);
            PG8_BAR; PG8_WAIT_L(0); PG8_MMA(1, 0, At, B0); PG8_BAR; PG8_SCHED;
            PG8_STAGE(PG8_SB(0, 1), b2 + hstep, voffB);
            PG8_WAIT_V(6); PG8_BAR; PG8_MMA(1, 1, At, B1); PG8_BAR;
            PG8_LDB(B0, 1, 0); PG8_SCHED; PG8_LDA(At, 1, 0); PG8_STAGE(PG8_SA(0, 1), a2 + hstep, voffA);
            PG8_WAIT_L(8); PG8_BAR; PG8_WAIT_L(0); PG8_MMA(0, 0, At, B0); PG8_BAR; PG8_SCHED;
            PG8_LDB(B1, 1, 1); PG8_STAGE(PG8_SB(1, 0), b3, voffB);
            PG8_BAR; PG8_WAIT_L(0); PG8_MMA(0, 1, At, B1); PG8_BAR;
            PG8_LDA(At, 1, 1); PG8_STAGE(PG8_SA(1, 0), a3, voffA);
            PG8_BAR; PG8_WAIT_L(0); PG8_MMA(1, 0, At, B0); PG8_BAR; PG8_SCHED;
            PG8_STAGE(PG8_SB(1, 1), b3 + hstep, voffB);
            PG8_WAIT_V(6); PG8_BAR; PG8_MMA(1, 1, At, B1); PG8_BAR;
            }
        }
        if constexpr (ALIGN_EPI) { if (wr == 0) PG8_BAR; }
        if constexpr (!Epi::AFTER_DRAIN) { E(acc, cur, wr, wc, fr, fq); S.done(cur); }
        if (!has_next) break;
#pragma unroll
        for (int a = 0; a < 2; ++a)
#pragma unroll
            for (int b = 0; b < 2; ++b)
#pragma unroll
                for (int m = 0; m < 4; ++m)
#pragma unroll
                    for (int n = 0; n < 2; ++n) acc[a][b][m][n] = (f32x4){0.f, 0.f, 0.f, 0.f};
        cur = nxt; cA = nA; cB = nB; ++ui;
        if constexpr (ALIGN_EPI) { if (wr == 1) PG8_BAR; }
    }
    PG8_WAIT_V(0);
    if constexpr (!ALIGN_EPI) { if (wr == 0) PG8_BAR; }
    PG8_BAR;
    if constexpr (Epi::AFTER_DRAIN) { E.fused(acc, cur, wr, wc, fr, fq, lds, wid, lane); S.done(cur); }
#undef PG8_SA
#undef PG8_SB
#undef PG8_STAGE
#undef PG8_LDA
#undef PG8_LDB
#undef PG8_MMA
#undef PG8_WAIT_V
#undef PG8_WAIT_L
#undef PG8_BAR
#undef PG8_SCHED
}
}

#define LAS __attribute__((address_space(3)))
typedef unsigned short bf16_t;
typedef short bf16x8 __attribute__((ext_vector_type(8)));
typedef float f32x4 __attribute__((ext_vector_type(4)));
typedef float f32x2 __attribute__((ext_vector_type(2)));
typedef float f32x16 __attribute__((ext_vector_type(16)));
typedef unsigned u32x4 __attribute__((ext_vector_type(4)));
typedef unsigned u32x2 __attribute__((ext_vector_type(2)));
typedef __bf16 bf16x2_t __attribute__((ext_vector_type(2)));
using pg8::Unit;

constexpr int DM = 1024, SEQ = 4096, NB = 8, MIX = 2048, PLE = 256;
constexpr int TH = 4 * SEQ;
constexpr int GLA_NCOL = 6160, GLA_N = 6400;
constexpr float EPS = 1e-6f;
constexpr int LDS_BYTES = 147456;
constexpr int PTAB_OFF = LDS_BYTES - 256;

constexpr size_t MiB = 1u << 20;
constexpr size_t WS_WGLAIN = 1 * MiB;
constexpr size_t WS_WGLAOUT = 29 * MiB;
constexpr size_t WS_WKV = 37 * MiB;
constexpr size_t WS_WDIN = 45 * MiB;
constexpr size_t WS_WDOUT = 61 * MiB;
constexpr size_t WS_WPG = 69 * MiB;
constexpr size_t WS_WPP = 77 * MiB;
constexpr size_t WS_HBB = 80 * MiB;
constexpr size_t WS_RSB = 112 * MiB;
constexpr size_t WS_PBF = 113 * MiB;
constexpr size_t WS_GBUF = 121 * MiB;
constexpr size_t WS_HSS = 153 * MiB;
constexpr size_t WS_R0 = 160 * MiB;
constexpr size_t WS_R1 = 192 * MiB;
constexpr size_t WS_R2 = 224 * MiB;
constexpr size_t WS_R3 = 288 * MiB;
constexpr size_t WS_R4 = 352 * MiB;
constexpr size_t WS_HBA = 416 * MiB;
constexpr size_t WS_RSA = 448 * MiB;
constexpr size_t WS_END = 449 * MiB;

__device__ __forceinline__ unsigned pk_bf16(float lo, float hi) { f32x2 v = {lo, hi}; bf16x2_t b = __builtin_convertvector(v, bf16x2_t); return __builtin_bit_cast(unsigned, b); }
__device__ __forceinline__ float bf_lo(unsigned w) { return __uint_as_float(w << 16); }
__device__ __forceinline__ float bf_hi(unsigned w) { return __uint_as_float(w & 0xffff0000u); }
__device__ __forceinline__ float fast_exp(float x) { return __builtin_amdgcn_exp2f(x * 1.4426950408889634f); }
__device__ __forceinline__ float sigmoidf_(float x) { return __builtin_amdgcn_rcpf(1.f + fast_exp(-x)); }
__device__ __forceinline__ int lane_op() { int l; asm volatile("v_mbcnt_lo_u32_b32 %0, -1, 0\n\tv_mbcnt_hi_u32_b32 %0, -1, %0" : "=v"(l)); return l; }
__device__ __forceinline__ float shx(float v, int m) { return __builtin_bit_cast(float, __builtin_amdgcn_ds_bpermute((lane_op() ^ m) << 2, __builtin_bit_cast(int, v))); }
__device__ __forceinline__ float shl_(float v, int src) { return __builtin_bit_cast(float, __builtin_amdgcn_ds_bpermute(src << 2, __builtin_bit_cast(int, v))); }
__device__ __forceinline__ float x32_sum(float v) { auto rr = __builtin_amdgcn_permlane32_swap(__float_as_uint(v), __float_as_uint(v), false, false); return __uint_as_float(rr[0]) + __uint_as_float(rr[1]); }
__device__ __forceinline__ float x32_max(float v) { auto rr = __builtin_amdgcn_permlane32_swap(__float_as_uint(v), __float_as_uint(v), false, false); return fmaxf(__uint_as_float(rr[0]), __uint_as_float(rr[1])); }
__device__ __forceinline__ float wave_sum(float v) {
#pragma unroll
    for (int o = 1; o < 64; o <<= 1) v += shx(v, o);
    return v;
}
__device__ __forceinline__ float row_rstd(const float* rs, int r) {
    const f32x4* p = (const f32x4*)(rs + (size_t)r * 16);
    const f32x4 a = p[0], b = p[1], c = p[2], d = p[3];
    const float s = ((a[0] + a[1]) + (a[2] + a[3])) + ((b[0] + b[1]) + (b[2] + b[3])) + ((c[0] + c[1]) + (c[2] + c[3])) + ((d[0] + d[1]) + (d[2] + d[3]));
    return __builtin_amdgcn_rsqf(s * (1.f / DM) + EPS);
}

__device__ __forceinline__ f32x4 act4(f32x4 v, int act) {
    if (act == 1) { v[0] *= sigmoidf_(v[0]); v[1] *= sigmoidf_(v[1]); v[2] *= sigmoidf_(v[2]); v[3] *= sigmoidf_(v[3]); }
    if (act == 2) { v[0] = sigmoidf_(v[0]); v[1] = sigmoidf_(v[1]); v[2] = sigmoidf_(v[2]); v[3] = sigmoidf_(v[3]); }
    return v;
}
template <int ACT>
__device__ __forceinline__ void epi_store_bf16(const f32x4 (&acc)[2][2][4][2], bf16_t* base, int ldc, int row0, int col0, const float (&rs)[2][4], float scale) {
#pragma unroll
    for (int ai = 0; ai < 2; ++ai)
#pragma unroll
        for (int m = 0; m < 4; ++m) {
            bf16_t* rowp = base + (size_t)(row0 + ai * 128 + m * 16) * ldc + col0; const float s = rs[ai][m] * scale;
#pragma unroll
            for (int bj = 0; bj < 2; ++bj) {
                const f32x4 v0 = act4(acc[ai][bj][m][0] * s, ACT), v1 = act4(acc[ai][bj][m][1] * s, ACT);
                u32x4 w; w.x = pk_bf16(v0[0], v0[1]); w.y = pk_bf16(v0[2], v0[3]); w.z = pk_bf16(v1[0], v1[1]); w.w = pk_bf16(v1[2], v1[3]);
                *(u32x4*)(rowp + bj * 128) = w;
            }
        }
}
__device__ __forceinline__ void load_rs(float (&rs)[2][4], const float* rowss, int row0, int fq) {
#pragma unroll
    for (int ai = 0; ai < 2; ++ai)
#pragma unroll
        for (int m = 0; m < 4; ++m) {
            const f32x4 a = *((const f32x4*)(rowss + (size_t)(row0 + ai * 128 + m * 16) * 16) + fq);
            float s = (a[0] + a[1]) + (a[2] + a[3]); s += shx(s, 16); s = x32_sum(s);
            rs[ai][m] = __builtin_amdgcn_rsqf(s * (1.f / DM) + EPS);
        }
}

struct EpiGlaIn {
    static constexpr bool PERM = true, AFTER_DRAIN = false;
    const float* rowss; bf16_t *Q, *K, *V, *G;
    __device__ __forceinline__ void operator()(const f32x4 (&acc)[2][2][4][2], const Unit& u, int wr, int wc, int fr, int fq) const {
        const int row0 = u.pm * 256 + wr * 64 + fr, cw = wc * 32 + 8 * fq, pn = u.pn;
        float rs[2][4]; load_rs(rs, rowss, row0, fq);
        if (pn < 4) epi_store_bf16<0>(acc, Q, DM, row0, pn * 256 + cw, rs, 0.0625f);
        else if (pn < 8) epi_store_bf16<0>(acc, K, DM, row0, (pn - 4) * 256 + cw, rs, 1.f);
        else if (pn < 16) epi_store_bf16<0>(acc, V, MIX, row0, (pn - 8) * 256 + cw, rs, 1.f);
        else epi_store_bf16<1>(acc, G, MIX, row0, (pn - 16) * 256 + cw, rs, 1.f);
    }
};
template <int ACT1>
struct EpiProj2 {
    static constexpr bool PERM = true, AFTER_DRAIN = false;
    const float* rowss; bf16_t *O0, *O1; int nsplit; float scale0;
    __device__ __forceinline__ void operator()(const f32x4 (&acc)[2][2][4][2], const Unit& u, int wr, int wc, int fr, int fq) const {
        const int row0 = u.pm * 256 + wr * 64 + fr, cw = wc * 32 + 8 * fq, pn = u.pn;
        float rs[2][4]; load_rs(rs, rowss, row0, fq);
        if (pn < nsplit) epi_store_bf16<0>(acc, O0, MIX, row0, pn * 256 + cw, rs, scale0);
        else epi_store_bf16<ACT1>(acc, O1, MIX, row0, (pn - nsplit) * 256 + cw, rs, 1.f);
    }
};
struct EpiVT {
    static constexpr bool PERM = true, AFTER_DRAIN = false;
    const float* rowss; bf16_t* VT;
    __device__ __forceinline__ void operator()(const f32x4 (&acc)[2][2][4][2], const Unit& u, int wr, int wc, int fr, int fq) const {
        const int row0 = u.pm * 256 + wr * 64 + fr, col0 = u.pn * 256 + wc * 32 + 8 * fq;
        const float mine = row_rstd(rowss, col0 + (fr >> 3) * 128 + (fr & 7));
#pragma unroll
        for (int bj = 0; bj < 2; ++bj) {
            const int c = col0 + bj * 128, src = fq * 16 + bj * 8;
            f32x4 s0, s1;
            s0[0] = shl_(mine, src); s0[1] = shl_(mine, src + 1); s0[2] = shl_(mine, src + 2); s0[3] = shl_(mine, src + 3);
            s1[0] = shl_(mine, src + 4); s1[1] = shl_(mine, src + 5); s1[2] = shl_(mine, src + 6); s1[3] = shl_(mine, src + 7);
#pragma unroll
            for (int ai = 0; ai < 2; ++ai)
#pragma unroll
                for (int m = 0; m < 4; ++m) {
                    const f32x4 v0 = acc[ai][bj][m][0] * s0, v1 = acc[ai][bj][m][1] * s1;
                    u32x4 w; w.x = pk_bf16(v0[0], v0[1]); w.y = pk_bf16(v0[2], v0[3]); w.z = pk_bf16(v1[0], v1[1]); w.w = pk_bf16(v1[2], v1[3]);
                    const int ch = row0 + ai * 128 + m * 16;
                    *(u32x4*)(VT + ((((size_t)((c >> 12) * 8 + (ch >> 8)) * 128 + ((c & 4095) >> 5)) * 256 + (ch & 255)) * 32 + (c & 31))) = w;
                }
        }
    }
};
struct EpiGate {
    static constexpr bool PERM = true, AFTER_DRAIN = false;
    const float* rowss; bf16_t* Gb;
    __device__ __forceinline__ void operator()(const f32x4 (&acc)[2][2][4][2], const Unit& u, int wr, int wc, int fr, int fq) const {
        const int row0 = u.pm * 256 + wr * 64 + fr;
        float rs[2][4]; load_rs(rs, rowss, row0, fq);
        epi_store_bf16<2>(acc, Gb, DM, row0, u.pn * 256 + wc * 32 + 8 * fq, rs, 1.f);
    }
};
template <bool GATED>
struct EpiResid {
    static constexpr bool PERM = true, AFTER_DRAIN = false;
    const float* Hs; float* H; bf16_t* HB; float* rowss; const bf16_t* Gb;
    __device__ __forceinline__ void operator()(const f32x4 (&acc)[2][2][4][2], const Unit& u, int wr, int wc, int fr, int fq) const {
        const int row0 = u.pm * 256 + wr * 64 + fr, col0 = u.pn * 256 + wc * 32 + 8 * fq;
#pragma unroll
        for (int ai = 0; ai < 2; ++ai)
#pragma unroll
            for (int m = 0; m < 4; ++m) {
                const int row = row0 + ai * 128 + m * 16; float ss = 0.f;
#pragma unroll
                for (int bj = 0; bj < 2; ++bj) {
                    const size_t off = (size_t)row * DM + col0 + bj * 128;
                    f32x4 h0 = *(const f32x4*)(Hs + off), h1 = *(const f32x4*)(Hs + off + 4); f32x4 a0 = acc[ai][bj][m][0], a1 = acc[ai][bj][m][1];
                    if (GATED) {
                        const unsigned long long ga = __hip_atomic_load((const unsigned long long*)(Gb + off), __ATOMIC_RELAXED, __HIP_MEMORY_SCOPE_AGENT);
                        const unsigned long long gb = __hip_atomic_load((const unsigned long long*)(Gb + off + 4), __ATOMIC_RELAXED, __HIP_MEMORY_SCOPE_AGENT);
                        const unsigned g0 = (unsigned)ga, g1 = (unsigned)(ga >> 32), g2 = (unsigned)gb, g3 = (unsigned)(gb >> 32);
                        a0[0] *= bf_lo(g0); a0[1] *= bf_hi(g0); a0[2] *= bf_lo(g1); a0[3] *= bf_hi(g1);
                        a1[0] *= bf_lo(g2); a1[1] *= bf_hi(g2); a1[2] *= bf_lo(g3); a1[3] *= bf_hi(g3);
                    }
                    h0 += a0; h1 += a1;
                    *(f32x4*)(H + off) = h0; *(f32x4*)(H + off + 4) = h1;
                    u32x4 w; w.x = pk_bf16(h0[0], h0[1]); w.y = pk_bf16(h0[2], h0[3]); w.z = pk_bf16(h1[0], h1[1]); w.w = pk_bf16(h1[2], h1[3]);
                    *(u32x4*)(HB + off) = w;
                    ss += ((h0[0] * h0[0] + h0[1] * h0[1]) + (h0[2] * h0[2] + h0[3] * h0[3])) + ((h1[0] * h1[0] + h1[1] * h1[1]) + (h1[2] * h1[2] + h1[3] * h1[3]));
                }
                ss += shx(ss, 16); ss = x32_sum(ss);
                if (fq == 0) rowss[(size_t)row * 16 + u.pn * 4 + wc] = ss;
                asm volatile("" ::: "memory");
            }
    }
};

template <class Epi>
__device__ __forceinline__ void run_gemm_(int wv, LAS unsigned char* lds, const bf16_t* A, const bf16_t* Bt, int M, int N, int K, const Epi& E) {
    pg8::Gemm g{A, Bt, M, N, K}; pg8::StaticOrder S; S.init(M, N, (int)gridDim.x, (int)blockIdx.x);
    pg8::gemm_phase<Epi, pg8::StaticOrder, true, true>(lds, g, S, E, wv);
}

__device__ __forceinline__ void transpose_item(const float* W, int ldn, int ncols, int K, const float* scale, bf16_t* WT, LAS float* scr, int item, int lane) {
    const int nblk = ncols / 32, kb = item / nblk, nb = item % nblk, k0 = 64 * kb, n0 = 32 * nb;
#pragma unroll
    for (int i = 0; i < 8; ++i) { const int kk = 8 * i + (lane >> 3), n4 = (lane & 7) * 4; f32x4 v = *(const f32x4*)(W + (size_t)(k0 + kk) * ldn + n0 + n4); if (scale) v *= scale[k0 + kk];
        LAS float* d = scr + kk * 33 + n4; d[0] = v[0]; d[1] = v[1]; d[2] = v[2]; d[3] = v[3]; }
    asm volatile("s_waitcnt lgkmcnt(0)" ::: "memory");
    const int c = lane & 7;
#pragma unroll
    for (int j = 0; j < 4; ++j) { const int n = (lane >> 3) + 8 * j; const LAS float* s = scr + (8 * c) * 33 + n;
        u32x4 o; o.x = pk_bf16(s[0 * 33], s[1 * 33]); o.y = pk_bf16(s[2 * 33], s[3 * 33]); o.z = pk_bf16(s[4 * 33], s[5 * 33]); o.w = pk_bf16(s[6 * 33], s[7 * 33]);
        *(u32x4*)(WT + (size_t)(n0 + n) * K + k0 + 8 * c) = o; }
    asm volatile("s_waitcnt lgkmcnt(0)" ::: "memory");
}

struct Params {
    const float *x, *p, *norm_mix, *gla_w_in, *gla_w_gk2, *gla_b_gk, *gla_norm, *gla_w_out, *kv_norm, *w_kv, *diff_w_in, *diff_lambda, *diff_norm, *diff_w_out,
        *ple_norm, *ple_w_gate, *ple_w_proj, *final_norm;
    float* out; unsigned char* ws;
};

__device__ __forceinline__ void prologue_weights(const Params& a, LAS unsigned char* lds, int tid) {
    asm volatile("" : "+v"(tid));
    const int lane = tid & 63, wave = tid >> 6;
    LAS float* scr = (LAS float*)(lds + wave * 16384);
    const int gw = (int)blockIdx.x * 8 + wave, NGW = (int)gridDim.x * 8;
    unsigned char* ws = a.ws;
    constexpr int I_GIN = 16 * 192, I_GOUT = 32 * 32, I_KV = 16 * 128, I_DIN = 16 * 128, I_DOUT = 32 * 32, I_PG = 16 * 32, I_PP = 4 * 32;
    constexpr int NITEMS = 2 * I_GIN + 2 * I_GOUT + I_KV + 2 * I_DIN + 2 * I_DOUT + 4 * I_PG + 4 * I_PP;
    for (int it = gw; it < NITEMS; it += NGW) {
        int r = it;
        if (r < 2 * I_GIN) { const int i = r / I_GIN; r -= i * I_GIN;
            transpose_item(a.gla_w_in + (size_t)i * DM * GLA_NCOL, GLA_NCOL, 6144, DM, a.norm_mix + i * DM, (bf16_t*)(ws + WS_WGLAIN) + (size_t)i * GLA_N * DM, scr, r, lane); continue; }
        r -= 2 * I_GIN;
        if (r < 2 * I_GOUT) { const int i = r / I_GOUT; r -= i * I_GOUT;
            transpose_item(a.gla_w_out + (size_t)i * MIX * DM, DM, DM, MIX, nullptr, (bf16_t*)(ws + WS_WGLAOUT) + (size_t)i * DM * MIX, scr, r, lane); continue; }
        r -= 2 * I_GOUT;
        if (r < I_KV) { transpose_item(a.w_kv, 4096, 4096, DM, a.kv_norm, (bf16_t*)(ws + WS_WKV), scr, r, lane); continue; }
        r -= I_KV;
        if (r < 2 * I_DIN) { const int i = r / I_DIN; r -= i * I_DIN;
            transpose_item(a.diff_w_in + (size_t)i * DM * 4096, 4096, 4096, DM, a.norm_mix + (2 + i) * DM, (bf16_t*)(ws + WS_WDIN) + (size_t)i * 4096 * DM, scr, r, lane); continue; }
        r -= 2 * I_DIN;
        if (r < 2 * I_DOUT) { const int i = r / I_DOUT; r -= i * I_DOUT;
            transpose_item(a.diff_w_out + (size_t)i * MIX * DM, DM, DM, MIX, nullptr, (bf16_t*)(ws + WS_WDOUT) + (size_t)i * DM * MIX, scr, r, lane); continue; }
        r -= 2 * I_DOUT;
        if (r < 4 * I_PG) { const int i = r / I_PG; r -= i * I_PG;
            transpose_item(a.ple_w_gate + (size_t)i * DM * DM, DM, DM, DM, a.ple_norm + i * DM, (bf16_t*)(ws + WS_WPG) + (size_t)i * DM * DM, scr, r, lane); continue; }
        r -= 4 * I_PG;
        { const int i = r / I_PP; r -= i * I_PP;
            transpose_item(a.ple_w_proj + (size_t)i * PLE * DM, DM, DM, PLE, nullptr, (bf16_t*)(ws + WS_WPP) + (size_t)i * DM * PLE, scr, r, lane); }
    }
    const int gt = (int)blockIdx.x * 512 + tid, NGT = (int)gridDim.x * 512;
    for (int id = gt; id < 2 * 256 * 128; id += NGT) {
        const int i = id >> 15, rem = id & 32767, r = rem >> 7, k0 = (rem & 127) * 8;
        u32x4 w = {0u, 0u, 0u, 0u};
        if (r < 16) {
            const float* win = a.gla_w_in + (size_t)i * DM * GLA_NCOL + 6144 + r; const float* nm = a.norm_mix + i * DM + k0;
            float o[8];
#pragma unroll
            for (int jj = 0; jj < 8; ++jj) o[jj] = win[(size_t)(k0 + jj) * GLA_NCOL] * nm[jj];
            w.x = pk_bf16(o[0], o[1]); w.y = pk_bf16(o[2], o[3]); w.z = pk_bf16(o[4], o[5]); w.w = pk_bf16(o[6], o[7]);
        }
        *(u32x4*)((bf16_t*)(ws + WS_WGLAIN) + (size_t)i * GLA_N * DM + (size_t)(6144 + r) * DM + k0) = w;
    }
}

__device__ __forceinline__ void init_rows(const float* xh, bf16_t* HB, float* rowss, int tid) {
    asm volatile("" : "+v"(tid));
    const int lane = tid & 63, gw = (int)blockIdx.x * 8 + (tid >> 6), NGW = (int)gridDim.x * 8;
    for (int r = gw; r < TH; r += NGW) {
        const f32x4* xr = (const f32x4*)(xh + (size_t)r * DM) + lane; u32x2* br = (u32x2*)(HB + (size_t)r * DM) + lane;
        float s = 0.f;
#pragma unroll
        for (int j = 0; j < 4; ++j) { const f32x4 v = __builtin_nontemporal_load(xr + 64 * j); u32x2 w; w.x = pk_bf16(v[0], v[1]); w.y = pk_bf16(v[2], v[3]); br[64 * j] = w; s += (v[0] * v[0] + v[1] * v[1]) + (v[2] * v[2] + v[3] * v[3]); }
        s = wave_sum(s);
        if (lane < 16) rowss[(size_t)r * 16 + lane] = (lane == 0) ? s : 0.f;
    }
}
__device__ __forceinline__ void final_rows(float* H, const float* gain, int tid) {
    asm volatile("" : "+v"(tid));
    const int lane = tid & 63, gw = (int)blockIdx.x * 8 + (tid >> 6), NGW = (int)gridDim.x * 8;
    for (int r = gw; r < TH; r += NGW) {
        f32x4* hr = (f32x4*)(H + (size_t)r * DM) + lane; const f32x4* gr = (const f32x4*)gain + lane;
        f32x4 v[4]; float s = 0.f;
#pragma unroll
        for (int j = 0; j < 4; ++j) { v[j] = __builtin_nontemporal_load(hr + 64 * j); s += (v[j][0] * v[j][0] + v[j][1] * v[j][1]) + (v[j][2] * v[j][2] + v[j][3] * v[j][3]); }
        const float rstd = 1.f / sqrtf(wave_sum(s) * (1.f / DM) + EPS);
#pragma unroll
        for (int j = 0; j < 4; ++j) __builtin_nontemporal_store(v[j] * rstd * gr[64 * j], hr + 64 * j);
    }
}
__device__ __forceinline__ void convert_p(const float* ph, bf16_t* PBF, int tid) {
    asm volatile("" : "+v"(tid));
    const int gt = (int)blockIdx.x * 512 + tid, NGT = (int)gridDim.x * 512;
    for (int i = gt; i < TH * PLE / 8; i += NGT) {
        const f32x4 a = __builtin_nontemporal_load((const f32x4*)ph + 2 * i), b = __builtin_nontemporal_load((const f32x4*)ph + 2 * i + 1);
        u32x4 w; w.x = pk_bf16(a[0], a[1]); w.y = pk_bf16(a[2], a[3]); w.z = pk_bf16(b[0], b[1]); w.w = pk_bf16(b[2], b[3]);
        ((u32x4*)PBF)[i] = w;
    }
}
__device__ __forceinline__ void gla_norm_gate(bf16_t* VO, const bf16_t* SG, const float* HSS, const float* gnorm, int tid) {
    asm volatile("" : "+v"(tid));
    const int lane = tid & 63, gw = (int)blockIdx.x * 8 + (tid >> 6), NGW = (int)gridDim.x * 8;
    const f32x4 g0 = *(const f32x4*)(gnorm + lane * 8), g1 = *(const f32x4*)(gnorm + lane * 8 + 4);
    for (int r = gw; r < TH; r += NGW) {
        const float hp = HSS[(size_t)r * 64 + lane];
        float hs = hp; hs += shx(hs, 1); hs += shx(hs, 2); hs += shx(hs, 4); hs += shx(hs, 8);
#pragma unroll
        for (int j = 0; j < 4; ++j) {
            const float rstd = __builtin_amdgcn_rsqf(shl_(hs, j * 16) * (1.f / 512.f) + EPS);
            u32x4* op = (u32x4*)(VO + (size_t)r * MIX + j * 512 + lane * 8); const u32x4 o = *op; const u32x4 s = *(const u32x4*)(SG + (size_t)r * MIX + j * 512 + lane * 8);
            u32x4 w;
            w.x = pk_bf16(bf_lo(o.x) * rstd * g0[0] * bf_lo(s.x), bf_hi(o.x) * rstd * g0[1] * bf_hi(s.x));
            w.y = pk_bf16(bf_lo(o.y) * rstd * g0[2] * bf_lo(s.y), bf_hi(o.y) * rstd * g0[3] * bf_hi(s.y));
            w.z = pk_bf16(bf_lo(o.z) * rstd * g1[0] * bf_lo(s.z), bf_hi(o.z) * rstd * g1[1] * bf_hi(s.z));
            w.w = pk_bf16(bf_lo(o.w) * rstd * g1[2] * bf_lo(s.w), bf_hi(o.w) * rstd * g1[3] * bf_hi(s.w));
            *op = w;
        }
    }
}

#define MFMA32(a, b, c) __builtin_amdgcn_mfma_f32_32x32x16_bf16((a), (b), (c), 0, 0, 0)
#define LDSV(T, off) (*(const LAS T*)(lds + (off)))

#define SB_() __builtin_amdgcn_sched_barrier(0)
template <int N>
__device__ __forceinline__ f32x16 chain_ab(LAS unsigned char* lds, int ao, int bo, f32x16 acc) {
    constexpr int D = 5;
    bf16x8 a[8], b[8];
#pragma unroll
    for (int s = 0; s < D && s < N; ++s) { a[s] = LDSV(bf16x8, ao + 32 * s); b[s] = LDSV(bf16x8, bo + 32 * s); }
    SB_();
#pragma unroll
    for (int s = 0; s < N; ++s) {
        if (s + D < N) { a[(s + D) & 7] = LDSV(bf16x8, ao + 32 * (s + D)); b[(s + D) & 7] = LDSV(bf16x8, bo + 32 * (s + D)); }
        SB_();
        acc = MFMA32(a[s & 7], b[s & 7], acc);
        SB_();
    }
    return acc;
}

__device__ __forceinline__ void gla_lowrank(LAS unsigned char* lds, const bf16_t* HB, const bf16_t* W16, const float* rowss, float* GLR, int vcu, int G, int wv) {
    const int wid = wv;
    for (int item = vcu; item < TH / 64; item += G) {
        const int lane = lane_op(), tid = wid * 64 + lane, l32 = lane & 31, hi = lane >> 5;
        constexpr int PP = 2064;
        __syncthreads();
        {
            const bf16_t* gp = HB + (size_t)item * 64 * DM;
            u32x4 t[16];
#pragma unroll
            for (int k = 0; k < 16; ++k) { const int p = tid + 512 * k; t[k] = *(const u32x4*)(gp + (size_t)(p >> 7) * DM + (p & 127) * 8); }
#pragma unroll
            for (int k = 0; k < 16; ++k) { const int p = tid + 512 * k; *(LAS u32x4*)(lds + (p >> 7) * PP + (p & 127) * 16) = t[k]; }
        }
        const bf16_t* gb = W16 + (size_t)l32 * DM + 128 * wid + 8 * hi;
        bf16x8 bq[8];
#pragma unroll
        for (int s = 0; s < 8; ++s) bq[s] = *(const bf16x8*)(gb + 16 * s);
        __syncthreads();
        const int ao = l32 * PP + (128 * wid + 8 * hi) * 2;
        f32x16 c0, c1;
#pragma unroll
        for (int r = 0; r < 16; ++r) { c0[r] = 0.f; c1[r] = 0.f; }
#pragma unroll
        for (int s = 0; s < 8; ++s) { c0 = MFMA32(LDSV(bf16x8, ao + 32 * s), bq[s], c0); c1 = MFMA32(LDSV(bf16x8, ao + 32 * PP + 32 * s), bq[s], c1); }
        __syncthreads();
#pragma unroll
        for (int r = 0; r < 16; ++r) { *(LAS float*)(lds + (((wid * 2 + 0) * 16 + r) * 64 + lane) * 4) = c0[r]; *(LAS float*)(lds + (((wid * 2 + 1) * 16 + r) * 64 + lane) * 4) = c1[r]; }
        __syncthreads();
        {
            const int pos = tid >> 3, g2 = (tid & 7) * 2, pb = pos >> 5, p5 = pos & 31, r = 4 * (p5 >> 3) + (p5 & 3), h2 = (p5 >> 2) & 1;
            float s0 = 0.f, s1 = 0.f;
#pragma unroll
            for (int w = 0; w < 8; ++w) { const f32x2 v = LDSV(f32x2, (((w * 2 + pb) * 16 + r) * 64 + h2 * 32 + g2) * 4); s0 += v[0]; s1 += v[1]; }
            const float rs = row_rstd(rowss, item * 64 + pos);
            *(f32x2*)(GLR + ((size_t)item * 64 + pos) * 16 + g2) = (f32x2){s0 * rs, s1 * rs};
        }
    }
    __syncthreads();
}

__device__ __forceinline__ void gla_prep(LAS unsigned char* lds, bf16_t* Q, const bf16_t* Kx, const float* GLR, const float* w2, const float* bgk, bf16_t* KD, bf16_t* SC, float* EB, int vcu, int G, int wv) {
    constexpr int QP = 528, OFF_QT = 0, OFF_KT = 64 * QP, OFF_TOT = 2 * 64 * QP, OFF_GL = OFF_TOT + 4096, OFF_END = OFF_GL + 4096;
    static_assert(OFF_END <= LDS_BYTES, "gla prep lds");
    const int wid = wv;
    for (int item = vcu; item < 16 * 64; item += G) {
        const int lane = lane_op(), l32 = lane & 31, hi = lane >> 5;
        const int qtr = wid >> 1, dp = (wid & 1) * 64 + lane, d0 = 2 * dp;
        const int bh = item >> 6, c = item & 63, b = bh >> 2, h = bh & 3;
        const size_t tok0 = (size_t)b * SEQ + (size_t)c * 64 + 16 * qtr;
        bf16_t* qg = Q + tok0 * DM + h * 256 + d0;
        const bf16_t* kg = Kx + tok0 * DM + h * 256 + d0;
        unsigned qr[16], kr[16];
#pragma unroll
        for (int i = 0; i < 16; ++i) { qr[i] = *(const unsigned*)(qg + (size_t)i * DM); kr[i] = *(const unsigned*)(kg + (size_t)i * DM); }
        float wa[16], wb[16];
#pragma unroll
        for (int r = 0; r < 16; ++r) { const f32x2 t = *(const f32x2*)(w2 + r * 1024 + h * 256 + d0); wa[r] = t[0]; wb[r] = t[1]; }
        const f32x2 bb = *(const f32x2*)(bgk + h * 256 + d0);
        __syncthreads();
        if (wid < 4) {
            const int t4 = wid * 64 + lane;
            *(LAS f32x4*)(lds + OFF_GL + t4 * 16) = *(const f32x4*)(GLR + ((size_t)b * SEQ + (size_t)c * 64) * 16 + t4 * 4);
        }
        __syncthreads();
        const int gl = OFF_GL + 16 * qtr * 64;
        float c0[16], c1[16]; float a0 = 0.f, a1 = 0.f;
#pragma unroll
        for (int i = 0; i < 16; ++i) {
            const f32x4 g0 = LDSV(f32x4, gl + i * 64), g1 = LDSV(f32x4, gl + i * 64 + 16), g2 = LDSV(f32x4, gl + i * 64 + 32), g3 = LDSV(f32x4, gl + i * 64 + 48);
            float x0 = bb[0], x1 = bb[1];
#pragma unroll
            for (int r = 0; r < 4; ++r) { x0 += g0[r] * wa[r]; x1 += g0[r] * wb[r]; }
#pragma unroll
            for (int r = 0; r < 4; ++r) { x0 += g1[r] * wa[4 + r]; x1 += g1[r] * wb[4 + r]; }
#pragma unroll
            for (int r = 0; r < 4; ++r) { x0 += g2[r] * wa[8 + r]; x1 += g2[r] * wb[8 + r]; }
#pragma unroll
            for (int r = 0; r < 4; ++r) { x0 += g3[r] * wa[12 + r]; x1 += g3[r] * wb[12 + r]; }
            a0 += (fminf(x0, 0.f) - __logf(1.f + fast_exp(-fabsf(x0)))) * 0.0625f;
            a1 += (fminf(x1, 0.f) - __logf(1.f + fast_exp(-fabsf(x1)))) * 0.0625f;
            c0[i] = a0; c1[i] = a1;
        }
        *(LAS f32x2*)(lds + OFF_TOT + (qtr * 256 + d0) * 4) = (f32x2){a0, a1};
        __syncthreads();
        const f32x2 t0 = LDSV(f32x2, OFF_TOT + (0 * 256 + d0) * 4), t1 = LDSV(f32x2, OFF_TOT + (1 * 256 + d0) * 4), t2 = LDSV(f32x2, OFF_TOT + (2 * 256 + d0) * 4), t3 = LDSV(f32x2, OFF_TOT + (3 * 256 + d0) * 4);
        const float of0 = (qtr > 0 ? t0[0] : 0.f) + (qtr > 1 ? t1[0] : 0.f) + (qtr > 2 ? t2[0] : 0.f);
        const float of1 = (qtr > 0 ? t0[1] : 0.f) + (qtr > 1 ? t1[1] : 0.f) + (qtr > 2 ? t2[1] : 0.f);
        const float bl0 = (t0[0] + t1[0]) + (t2[0] + t3[0]), bl1 = (t0[1] + t1[1]) + (t2[1] + t3[1]);
        const float ebl0 = fast_exp(bl0), ebl1 = fast_exp(bl1);
        unsigned kd0[8], kd1[8];
#pragma unroll
        for (int i = 0; i < 16; i += 2) {
            float kda[2], kdb[2];
#pragma unroll
            for (int e = 0; e < 2; ++e) {
                const int ii = i + e; const float b0 = of0 + c0[ii], b1 = of1 + c1[ii];
                const float q0 = bf_lo(qr[ii]), q1 = bf_hi(qr[ii]), k0 = bf_lo(kr[ii]), k1 = bf_hi(kr[ii]);
                const int pos = 16 * qtr + ii;
                const unsigned qt = pk_bf16(q0 * fast_exp(b0), q1 * fast_exp(b1));
                *(LAS unsigned*)(lds + OFF_QT + pos * QP + d0 * 2) = qt;
                *(unsigned*)(qg + (size_t)ii * DM) = qt;
                const float kn0 = k0 * fast_exp(-b0), kn1 = k1 * fast_exp(-b1);
                *(LAS unsigned*)(lds + OFF_KT + pos * QP + d0 * 2) = pk_bf16(kn0, kn1);
                kda[e] = kn0 * ebl0; kdb[e] = kn1 * ebl1;
            }
            kd0[i >> 1] = pk_bf16(kda[0], kda[1]); kd1[i >> 1] = pk_bf16(kdb[0], kdb[1]);
        }
        bf16_t* kdg = KD + ((size_t)item * 256 + d0) * 64 + 16 * qtr;
        *(u32x4*)(kdg) = (u32x4){kd0[0], kd0[1], kd0[2], kd0[3]};
        *(u32x4*)(kdg + 8) = (u32x4){kd0[4], kd0[5], kd0[6], kd0[7]};
        *(u32x4*)(kdg + 64) = (u32x4){kd1[0], kd1[1], kd1[2], kd1[3]};
        *(u32x4*)(kdg + 72) = (u32x4){kd1[4], kd1[5], kd1[6], kd1[7]};
        if (qtr == 0) *(f32x2*)(EB + (size_t)item * 256 + d0) = (f32x2){ebl0, ebl1};
        __syncthreads();
        if (wid < 3) {
            const int ib = wid > 0 ? 1 : 0, jb = wid > 1 ? 1 : 0;
            const int ao = OFF_KT + (32 * jb + l32) * QP + hi * 16, bo = OFF_QT + (32 * ib + l32) * QP + hi * 16;
            f32x16 acc;
#pragma unroll
            for (int r = 0; r < 16; ++r) acc[r] = 0.f;
            acc = chain_ab<16>(lds, ao, bo, acc);
            if (ib == jb) {
#pragma unroll
                for (int r = 0; r < 16; ++r) if (8 * (r >> 2) + 4 * hi + (r & 3) > l32) acc[r] = 0.f;
            }
            bf16_t* scg = SC + ((size_t)item * 64 + 32 * ib + l32) * 64 + 32 * jb + 4 * hi;
#pragma unroll
            for (int r4 = 0; r4 < 4; ++r4)
                *(u32x2*)(scg + 8 * r4) = (u32x2){pk_bf16(acc[4 * r4], acc[4 * r4 + 1]), pk_bf16(acc[4 * r4 + 2], acc[4 * r4 + 3])};
        }
    }
    __syncthreads();
}

__device__ __forceinline__ void gla_scan(LAS unsigned char* lds, const bf16_t* Q, const bf16_t* KD, const bf16_t* SC, const float* EB, const bf16_t* VO, bf16_t* OUT, float* HSS, int vcu, int G, int wv) {
    constexpr int QP = 528, KDP = 144, OFF_QT = 0, OFF_KD = 64 * QP, OFF_VT = OFF_KD + 256 * KDP, OFF_ST = OFF_VT + 32 * 144, OFF_SC = OFF_ST + 32 * QP,
                  OFF_EB = OFF_SC + 64 * 144, OFF_END = OFF_EB + 1024;
    static_assert(OFF_END <= LDS_BYTES, "gla lds");
    const int wid = wv;
    for (int item = vcu; item < 256; item += G) {
        const int lane = lane_op(), tid = wid * 64 + lane, l32 = lane & 31, hi = lane >> 5;
        const int bh = item >> 4, sl = item & 15, b = bh >> 2, h = bh & 3;
        const size_t tokb = (size_t)b * SEQ;
        const bf16_t* gq = Q + (tokb + (tid >> 5)) * DM + h * 256 + (tid & 31) * 8;
        const bf16_t* gkd = KD + ((size_t)bh * 64 * 256 + (tid >> 3)) * 64 + (tid & 7) * 8;
        const bf16_t* gsc = SC + ((size_t)bh * 64 * 64 + (tid >> 3)) * 64 + (tid & 7) * 8;
        const bf16_t* gv = VO + (tokb + ((tid & 255) >> 2)) * MIX + h * 512 + sl * 32 + (tid & 3) * 8;
        const float* geb = EB + (size_t)bh * 64 * 256 + (tid & 63) * 4;
        const int lq = OFF_QT + (tid >> 5) * QP + (tid & 31) * 16, lkd = OFF_KD + (tid >> 3) * KDP + (tid & 7) * 16, lsc = OFF_SC + (tid >> 3) * 144 + (tid & 7) * 16;
        __syncthreads();
        for (int i = tid; i < 32 * QP / 4; i += 512) *(LAS unsigned*)(lds + OFF_ST + 4 * i) = 0u;
        f32x16 S, S2;
#pragma unroll
        for (int r = 0; r < 16; ++r) { S[r] = 0.f; S2[r] = 0.f; }
        const int blk = wid, blk2 = wid - 2;
        u32x4 pq[2][4], pk[2][4], psc[2], pv[2];
        pv[0] = (u32x4){0u, 0u, 0u, 0u}; pv[1] = pv[0];
#pragma unroll
        for (int par = 0; par < 2; ++par) {
#pragma unroll
            for (int k = 0; k < 4; ++k) { pq[par][k] = *(const u32x4*)(gq + ((size_t)par * 64 + k * 16) * DM); pk[par][k] = *(const u32x4*)(gkd + ((size_t)par * 256 + k * 64) * 64); }
            psc[par] = *(const u32x4*)(gsc + (size_t)par * 64 * 64);
            if (tid < 256) pv[par] = *(const u32x4*)(gv + (size_t)par * 64 * MIX); else if (tid < 320) pv[par] = *(const u32x4*)(geb + (size_t)par * 256);
        }
        for (int c2 = 0; c2 < 64; c2 += 2) {
#pragma unroll
          for (int par = 0; par < 2; ++par) {
            const int c = c2 + par;
#pragma unroll
            for (int k = 0; k < 4; ++k) { *(LAS u32x4*)(lds + lq + k * 16 * QP) = pq[par][k]; *(LAS u32x4*)(lds + lkd + k * 64 * KDP) = pk[par][k]; }
            *(LAS u32x4*)(lds + lsc) = psc[par];
            if (tid < 256) {
                const int pos = tid >> 2, e0 = (tid & 3) * 8;
                LAS bf16_t* vt = (LAS bf16_t*)(lds + OFF_VT) + pos;
                const u32x4 v = pv[par];
                vt[(e0 + 0) * 72] = (bf16_t)(v.x & 0xffffu); vt[(e0 + 1) * 72] = (bf16_t)(v.x >> 16);
                vt[(e0 + 2) * 72] = (bf16_t)(v.y & 0xffffu); vt[(e0 + 3) * 72] = (bf16_t)(v.y >> 16);
                vt[(e0 + 4) * 72] = (bf16_t)(v.z & 0xffffu); vt[(e0 + 5) * 72] = (bf16_t)(v.z >> 16);
                vt[(e0 + 6) * 72] = (bf16_t)(v.w & 0xffffu); vt[(e0 + 7) * 72] = (bf16_t)(v.w >> 16);
            } else if (tid < 320) *(LAS u32x4*)(lds + OFF_EB + (tid & 63) * 16) = pv[par];
            if (c + 2 < 64) {
                const size_t cn = (size_t)(c + 2);
#pragma unroll
                for (int k = 0; k < 4; ++k) { pq[par][k] = *(const u32x4*)(gq + (cn * 64 + k * 16) * DM); pk[par][k] = *(const u32x4*)(gkd + (cn * 256 + k * 64) * 64); }
                psc[par] = *(const u32x4*)(gsc + cn * 64 * 64);
                if (tid < 256) pv[par] = *(const u32x4*)(gv + cn * 64 * MIX); else if (tid < 320) pv[par] = *(const u32x4*)(geb + cn * 256);
            }
            __syncthreads();
            f32x16 acc;
#pragma unroll
            for (int r = 0; r < 16; ++r) acc[r] = 0.f;
            if (wid < 2) {
                const int pb = wid;
                acc = chain_ab<16>(lds, OFF_ST + l32 * QP + hi * 16, OFF_QT + (32 * pb + l32) * QP + hi * 16, acc);
                const int ao = OFF_VT + l32 * 144 + hi * 16, bo = OFF_SC + (32 * pb + l32) * 144 + hi * 16;
                if (pb == 1) acc = chain_ab<4>(lds, ao, bo, acc); else acc = chain_ab<2>(lds, ao, bo, acc);
                const size_t tok = tokb + (size_t)c * 64 + 32 * pb + l32;
                bf16_t* orow = OUT + tok * MIX + h * 512 + sl * 32 + 4 * hi; float ss = 0.f;
#pragma unroll
                for (int r4 = 0; r4 < 4; ++r4) {
                    *(u32x2*)(orow + 8 * r4) = (u32x2){pk_bf16(acc[4 * r4], acc[4 * r4 + 1]), pk_bf16(acc[4 * r4 + 2], acc[4 * r4 + 3])};
                    ss += (acc[4 * r4] * acc[4 * r4] + acc[4 * r4 + 1] * acc[4 * r4 + 1]) + (acc[4 * r4 + 2] * acc[4 * r4 + 2] + acc[4 * r4 + 3] * acc[4 * r4 + 3]);
                }
                ss = x32_sum(ss);
                if (hi == 0) HSS[tok * 64 + h * 16 + sl] = ss;
            }
            if (wid >= 2) {
#pragma unroll
                for (int r4 = 0; r4 < 4; ++r4) { const f32x4 eb = LDSV(f32x4, OFF_EB + (32 * blk + 8 * r4 + 4 * hi) * 4);
                    S[4 * r4] *= eb[0]; S[4 * r4 + 1] *= eb[1]; S[4 * r4 + 2] *= eb[2]; S[4 * r4 + 3] *= eb[3]; }
                S = chain_ab<4>(lds, OFF_KD + (32 * blk + l32) * KDP + hi * 16, OFF_VT + l32 * 144 + hi * 16, S);
                if (wid < 4) {
#pragma unroll
                    for (int r4 = 0; r4 < 4; ++r4) { const f32x4 eb = LDSV(f32x4, OFF_EB + (32 * blk2 + 8 * r4 + 4 * hi) * 4);
                        S2[4 * r4] *= eb[0]; S2[4 * r4 + 1] *= eb[1]; S2[4 * r4 + 2] *= eb[2]; S2[4 * r4 + 3] *= eb[3]; }
                    S2 = chain_ab<4>(lds, OFF_KD + (32 * blk2 + l32) * KDP + hi * 16, OFF_VT + l32 * 144 + hi * 16, S2);
                }
            }
            __syncthreads();
            if (wid >= 2) {
#pragma unroll
                for (int r4 = 0; r4 < 4; ++r4)
                    *(LAS u32x2*)(lds + OFF_ST + l32 * QP + (32 * blk + 8 * r4 + 4 * hi) * 2) = (u32x2){pk_bf16(S[4 * r4], S[4 * r4 + 1]), pk_bf16(S[4 * r4 + 2], S[4 * r4 + 3])};
                if (wid < 4) {
#pragma unroll
                    for (int r4 = 0; r4 < 4; ++r4)
                        *(LAS u32x2*)(lds + OFF_ST + l32 * QP + (32 * blk2 + 8 * r4 + 4 * hi) * 2) = (u32x2){pk_bf16(S2[4 * r4], S2[4 * r4 + 1]), pk_bf16(S2[4 * r4 + 2], S2[4 * r4 + 3])};
                }
            }
          }
        }
    }
    __syncthreads();
}

__device__ __forceinline__ void attn_phase(LAS unsigned char* lds, const bf16_t* QO, bf16_t* OUT, const bf16_t* KK, const bf16_t* VT, const bf16_t* SG, const float* lam4, const float* gnorm, float lambda_init, int vcu, int G, int wv) {
    constexpr int KP = 272, VP = 80, OFF_V = 2 * 32 * KP, STG = OFF_V + 256 * VP, OFF_Q = 2 * STG;
    static_assert(OFF_Q + 8 * 32 * KP <= PTAB_OFF && 4 * 128 * 64 * 4 <= PTAB_OFF, "attn lds");
    const int wid = wv, j = wid >> 2, wq = wid & 3;
    float lam;
    { const int lane0 = lane_op();
      const float s01 = wave_sum(lam4[lane0] * lam4[128 + lane0] + lam4[64 + lane0] * lam4[192 + lane0]);
      const float s23 = wave_sum(lam4[256 + lane0] * lam4[384 + lane0] + lam4[320 + lane0] * lam4[448 + lane0]);
      lam = expf(s01) - expf(s23) + lambda_init; }
    for (int item = vcu; item < 256; item += G) {
        const int grp = item >> 5, w32 = item & 31, j16 = w32 & 15;
        for (int ui = 0; ui < 4; ++ui) {
            const int bh = grp * 4 + 2 * (ui >> 1) + (w32 >> 4), b = bh >> 3, h = bh & 7;
            const size_t tokb = (size_t)b * SEQ;
            const int qb = (ui & 1) ? j16 : 31 - j16;
            const int q0 = 128 * qb + 32 * wq, NT = 4 * (qb + 1), tdiag = 4 * qb + wq;
            const int lane = lane_op(), tid = wid * 64 + lane, l32 = lane & 31, hi = lane >> 5, c4 = tid & 3;
            const int lK = (tid >> 4) * KP + (tid & 15) * 16;
            const int lV = OFF_V + (tid >> 2) * VP + (16 * (c4 >> 1) + 4 * (c4 & 1)) * 2;
            {
                const bf16_t* qsrc = QO + (tokb + q0) * MIX + h * 256 + j * 128;
#pragma unroll
                for (int i = 0; i < 8; ++i) { const int p = lane + 64 * i, row = p >> 4, c16 = p & 15;
                    *(LAS u32x4*)(lds + OFF_Q + wid * (32 * KP) + row * KP + c16 * 16) = *(const u32x4*)(qsrc + (size_t)row * MIX + c16 * 8); }
            }
            const int qo = OFF_Q + wid * (32 * KP) + l32 * KP + hi * 16;
            f32x16 o[8];
#pragma unroll
            for (int db = 0; db < 8; ++db)
#pragma unroll
                for (int r = 0; r < 16; ++r) o[db][r] = 0.f;
            float mrun = 0.f, lsum = 0.f;
            const bf16_t* gK1 = KK + (tokb + (tid >> 4)) * MIX + h * 256 + (tid & 15) * 8;
            const bf16_t* gV1 = VT + (((size_t)(b * 8 + h) * 128) * 256 + (tid >> 2)) * 32 + c4 * 8;
            u32x4 ra0, ra1, ra2, ra3;
            f32x16 negm;
#pragma unroll
            for (int r = 0; r < 16; ++r) negm[r] = 0.f;
#define ATT_LOAD(R, tt) do { const bf16_t* k1_ = gK1 + (size_t)(tt) * 32 * MIX; const bf16_t* v1_ = gV1 + (size_t)(tt) * 8192; \
                R##0 = *(const u32x4*)k1_; R##1 = *(const u32x4*)(k1_ + 128); R##2 = *(const u32x4*)v1_; R##3 = *(const u32x4*)(v1_ + 4096); } while (0)
#define ATT_WRITE(R, base) do { const u32x4 w2_ = R##2, w3_ = R##3; \
                *(LAS u32x4*)(lds + (base) + lK) = R##0; *(LAS u32x4*)(lds + (base) + 32 * KP + lK) = R##1; \
                *(LAS u32x2*)(lds + (base) + lV) = (u32x2){w2_.x, w2_.y}; *(LAS u32x2*)(lds + (base) + lV + 16) = (u32x2){w2_.z, w2_.w}; \
                *(LAS u32x2*)(lds + (base) + lV + 128 * VP) = (u32x2){w3_.x, w3_.y}; *(LAS u32x2*)(lds + (base) + lV + 128 * VP + 16) = (u32x2){w3_.z, w3_.w}; } while (0)
#define ATT_TILE(cur, t) do { if ((t) <= tdiag) { \
                const int ko = (cur) + j * 32 * KP + l32 * KP + hi * 16, vo = (cur) + OFF_V + l32 * VP + hi * 16; \
                f32x16 sT; \
                bf16x8 vf[4]; \
                { bf16x8 kf[4], qq[4]; \
                  _Pragma("unroll") for (int s = 0; s < 3; ++s) { kf[s] = LDSV(bf16x8, ko + 32 * s); qq[s] = LDSV(bf16x8, qo + 32 * s); } \
                  SB_(); \
                  _Pragma("unroll") for (int s = 0; s < 8; ++s) { \
                      if (s + 3 < 8) { kf[(s + 3) & 3] = LDSV(bf16x8, ko + 32 * (s + 3)); qq[(s + 3) & 3] = LDSV(bf16x8, qo + 32 * (s + 3)); } \
                      SB_(); sT = MFMA32(kf[s & 3], qq[s & 3], s == 0 ? negm : sT); SB_(); } } \
                _Pragma("unroll") for (int i = 0; i < 3; ++i) vf[i] = LDSV(bf16x8, vo + (i >> 1) * 32 * VP + (i & 1) * 32); \
                SB_(); \
                if ((t) == tdiag) { _Pragma("unroll") for (int r = 0; r < 16; ++r) if (8 * (r >> 2) + 4 * hi + (r & 3) > l32) sT[r] = -1e30f; } \
                float mx = sT[0]; \
                _Pragma("unroll") for (int r = 1; r < 16; ++r) mx = fmaxf(mx, sT[r]); \
                mx = x32_max(mx); \
                if ((t) == 0 || __any(mx > 8.f)) {         \
                    const float dl = ((t) == 0 || mx > 8.f) ? mx : 0.f, alpha = __builtin_amdgcn_exp2f(-dl); \
                    mrun += dl; lsum *= alpha; \
                    _Pragma("unroll") for (int r = 0; r < 16; ++r) { sT[r] -= dl; negm[r] = -mrun; } \
                    _Pragma("unroll") for (int db = 0; db < 8; ++db) _Pragma("unroll") for (int r = 0; r < 16; ++r) o[db][r] *= alpha; } \
                float ps = 0.f; \
                _Pragma("unroll") for (int r = 0; r < 16; ++r) { sT[r] = __builtin_amdgcn_exp2f(sT[r]); ps += sT[r]; } \
                lsum += ps; \
                const u32x4 p0 = {pk_bf16(sT[0], sT[1]), pk_bf16(sT[2], sT[3]), pk_bf16(sT[4], sT[5]), pk_bf16(sT[6], sT[7])}; \
                const u32x4 p1 = {pk_bf16(sT[8], sT[9]), pk_bf16(sT[10], sT[11]), pk_bf16(sT[12], sT[13]), pk_bf16(sT[14], sT[15])}; \
                const bf16x8 pb0 = __builtin_bit_cast(bf16x8, p0), pb1 = __builtin_bit_cast(bf16x8, p1); \
                SB_(); \
                _Pragma("unroll") for (int i = 0; i < 16; ++i) { \
                    if (i + 3 < 16) vf[(i + 3) & 3] = LDSV(bf16x8, vo + ((i + 3) >> 1) * 32 * VP + ((i + 3) & 1) * 32); \
                    SB_(); o[i >> 1] = MFMA32(vf[i & 3], (i & 1) ? pb1 : pb0, o[i >> 1]); SB_(); } } } while (0)
            ATT_LOAD(ra, 0);
            ATT_WRITE(ra, 0);
            __syncthreads();
            for (int t = 0; t < NT; t += 2) {
                ATT_LOAD(ra, t + 1);
                ATT_TILE(0, t);
                ATT_WRITE(ra, STG);
                __syncthreads();
                if (t + 2 < NT) ATT_LOAD(ra, t + 2);
                ATT_TILE(STG, t + 1);
                if (t + 2 < NT) ATT_WRITE(ra, 0);
                __syncthreads();
            }
#undef ATT_LOAD
#undef ATT_TILE
#undef ATT_WRITE
            const float l = x32_sum(lsum), inv = 1.f / l;
            const int lane_e = lane_op(), l32e = lane_e & 31, hie = lane_e >> 5;
            const int xo = (wq * 128 * 64 + lane_e) * 4;
            if (j == 1) {
                const float f = lam * inv;
#pragma unroll
                for (int db = 0; db < 8; ++db)
#pragma unroll
                    for (int r = 0; r < 16; ++r) *(LAS float*)(lds + xo + (db * 16 + r) * 256) = o[db][r] * f;
            }
            __syncthreads();
            if (j == 0) {
                float ss = 0.f;
#pragma unroll
                for (int db = 0; db < 8; ++db) {
#pragma unroll
                    for (int r = 0; r < 16; ++r) { const float v = o[db][r] * inv - LDSV(float, xo + (db * 16 + r) * 256); o[db][r] = v; ss += v * v; }
                    asm volatile("" : "+v"(o[db]), "+v"(ss) :: "memory");
                }
                ss = x32_sum(ss);
                const float rstd = __builtin_amdgcn_rsqf(ss * (1.f / 256.f) + EPS) * (1.f - lambda_init);
                bf16_t* orow = OUT + (tokb + q0 + l32e) * MIX + h * 256 + 4 * hie; const bf16_t* grow = SG + (tokb + q0 + l32e) * MIX + h * 256 + 4 * hie;
#pragma unroll
                for (int db = 0; db < 8; ++db)
#pragma unroll
                    for (int r4 = 0; r4 < 4; ++r4) {
                        const int dv = 32 * db + 8 * r4;
                        const f32x4 g = *(const f32x4*)(gnorm + dv + 4 * hie); const u32x2 sg = *(const u32x2*)(grow + dv);
                        u32x2 w;
                        w.x = pk_bf16(o[db][4 * r4] * rstd * g[0] * bf_lo(sg.x), o[db][4 * r4 + 1] * rstd * g[1] * bf_hi(sg.x));
                        w.y = pk_bf16(o[db][4 * r4 + 2] * rstd * g[2] * bf_lo(sg.y), o[db][4 * r4 + 3] * rstd * g[3] * bf_hi(sg.y));
                        *(u32x2*)(orow + dv) = w;
                        if (r4 & 1) asm volatile("" ::: "memory");
                    }
            }
            __syncthreads();
        }
    }
}

#define XB_TMO      128
#define XB_XCNT(j)  (256  + 64 * (j))
#define XB_XSUB(j)  (1280 + 64 * (j))
#define XB_XGEN(j)  (2304 + 64 * (j))
#define XB_TOP      3328
#define XB_TOPGEN   3392
#define XCD_BAR_WORDS 3456
#define XB_SPIN_CAP (1u << 18)

__device__ __forceinline__ unsigned xb_ld(unsigned* p)              { return __hip_atomic_load(p, __ATOMIC_RELAXED, __HIP_MEMORY_SCOPE_AGENT); }
__device__ __forceinline__ unsigned xb_add(unsigned* p, unsigned v) { return __hip_atomic_fetch_add(p, v, __ATOMIC_RELAXED, __HIP_MEMORY_SCOPE_AGENT); }
__device__ __forceinline__ unsigned xb_xcc_id() { return (unsigned)__builtin_amdgcn_s_getreg((3 << 11) | 20) & 0xFu; }
#define XB_SPIN(cond, bar) do { unsigned _sp = 0; while (cond) { __builtin_amdgcn_s_sleep(1); \
    if ((++_sp & 255u) == 0u) { if (xb_ld(&(bar)[XB_TMO])) break; if (_sp > XB_SPIN_CAP) { atomicAdd(&(bar)[XB_TMO], 1u); break; } } } } while (0)

struct XcdBarrier {
    unsigned* bar; unsigned x;
    volatile LAS unsigned* st;
};

__device__ __forceinline__ XcdBarrier xcd_barrier_post(unsigned* bar, volatile LAS unsigned* st, bool t0) {
    XcdBarrier b; b.bar = bar; b.x = xb_xcc_id(); b.st = st;
    if (t0) (void)xb_add(&bar[XB_XCNT(b.x)], 1u);
    return b;
}
__device__ __forceinline__ void xcd_barrier_complete(unsigned* bar, unsigned x, unsigned& nloc, unsigned& nx) {
    const unsigned G = gridDim.x * gridDim.y * gridDim.z;
    unsigned sum, cnt, mine, sp = 0u;
    for (;;) {
        sum = 0u; cnt = 0u; mine = 0u;
#pragma unroll
        for (unsigned j = 0; j < 16; ++j) { const unsigned c = xb_ld(&bar[XB_XCNT(j)]); sum += c; cnt += (c > 0u) ? 1u : 0u; mine = (j == x) ? c : mine; }
        if (sum == G) break;
        __builtin_amdgcn_s_sleep(1);
        if ((++sp & 255u) == 0u) { if (xb_ld(&bar[XB_TMO])) break; if (sp > XB_SPIN_CAP) { atomicAdd(&bar[XB_TMO], 1u); break; } }
    }
    nloc = mine > 0u ? mine : 1u; nx = cnt > 0u ? cnt : 1u;
}

__device__ __forceinline__ void xcd_barrier(const XcdBarrier& b, bool t0) {
    asm volatile("s_waitcnt vmcnt(0)" ::: "memory");
    __syncthreads();
    if (t0) {
        unsigned* bar = b.bar;
        __builtin_amdgcn_s_waitcnt(0);
        unsigned nloc = b.st[0], nx = b.st[1];
        if (nloc == 0u) { xcd_barrier_complete(bar, b.x, nloc, nx); b.st[0] = nloc; b.st[1] = nx; }
        const unsigned old = xb_add(&bar[XB_XSUB(b.x)], 1u);
        const unsigned gen = old / nloc;
        if (old + 1u == (gen + 1u) * nloc) {
            __builtin_amdgcn_fence(__ATOMIC_RELEASE, "agent");
            asm volatile("s_waitcnt vmcnt(0)" ::: "memory");
            const unsigned og = xb_add(&bar[XB_TOP], 1u);
            const unsigned tg = og / nx;
            if (og + 1u == (tg + 1u) * nx) xb_add(&bar[XB_TOPGEN], 1u);
            else XB_SPIN(xb_ld(&bar[XB_TOPGEN]) == tg, bar);
            __builtin_amdgcn_fence(__ATOMIC_ACQUIRE, "agent");
            xb_add(&bar[XB_XGEN(b.x)], 1u);
            asm volatile("s_waitcnt vmcnt(0)" ::: "memory");
        } else {
            XB_SPIN(xb_ld(&bar[XB_XGEN(b.x)]) == gen, bar);
            __builtin_amdgcn_fence(__ATOMIC_ACQUIRE, "agent");
            asm volatile("s_waitcnt vmcnt(0)" ::: "memory");
        }
    }
    __syncthreads();
}

__device__ __forceinline__ unsigned long long ptab_get(LAS unsigned char*, int k) {
    const __attribute__((address_space(4))) unsigned long long* kp = (const __attribute__((address_space(4))) unsigned long long*)__builtin_amdgcn_kernarg_segment_ptr();
    asm volatile("" : "+s"(kp));
    return kp[k];
}
__global__ void __launch_bounds__(512) yoco_fwd(Params a) {
    extern __shared__ __attribute__((aligned(16))) unsigned char lds_raw[];
    LAS unsigned char* lds = (LAS unsigned char*)lds_raw;
    cg::grid_group grid = cg::this_grid();
    const int G = (int)gridDim.x, bx = (int)blockIdx.x;
    if (threadIdx.x < 64) ((LAS unsigned*)(lds + LDS_BYTES - 256))[threadIdx.x] = 0u;
    __syncthreads();
    const int wv = __builtin_amdgcn_readfirstlane((int)threadIdx.x >> 6);
#define tid (wv * 64 + lane_op())
#define run_gemm(...) run_gemm_(wv, __VA_ARGS__)
    const int vcu = (G % 8 == 0) ? (bx % 8) * (G / 8) + bx / 8 : bx;
#define PTR(T, k) ((T*)(__attribute__((address_space(1))) T*)ptab_get(lds, (k)))
#define WSP(T, off) ((T*)(__attribute__((address_space(1))) T*)(ptab_get(lds, 19) + (off)))
#define HBB WSP(bf16_t, WS_HBB)
#define HBA WSP(bf16_t, WS_HBA)
#define RSB WSP(float, WS_RSB)
#define RSA WSP(float, WS_RSA)
#define PBF WSP(bf16_t, WS_PBF)
#define GBUF WSP(bf16_t, WS_GBUF)
#define HSS WSP(float, WS_HSS)
#define R0 WSP(bf16_t, WS_R0)
#define R1 WSP(bf16_t, WS_R1)
#define R2 WSP(bf16_t, WS_R2)
#define R3 WSP(bf16_t, WS_R3)
#define R4 WSP(bf16_t, WS_R4)
#define ws ((unsigned char*)(__attribute__((address_space(1))) unsigned char*)ptab_get(lds, 19))
    const XcdBarrier bar = xcd_barrier_post((unsigned*)ws, (volatile LAS unsigned*)(lds + LDS_BYTES - 256), tid == 0);
#define GSYNC() xcd_barrier(bar, tid == 0)
    prologue_weights(a, lds, tid);
#pragma unroll 1
    for (int half = 0; half < 2; ++half) {
        const size_t tok0 = (size_t)half * TH;
#define H (PTR(float, 18) + tok0 * DM)
        init_rows(PTR(const float, 0) + tok0 * DM, HBB, RSB, tid);
        if (G == 0x7fffffff) grid.sync();
        GSYNC();
#pragma unroll 1
        for (int i = 0; i < 4; ++i) {
            if (i < 2) {
                gla_lowrank(lds, HBB, (const bf16_t*)(ws + WS_WGLAIN) + (size_t)i * GLA_N * DM + (size_t)6144 * DM, RSB, HSS, vcu, G, wv);
                { EpiGlaIn E{RSB, R0, R1, R2, R3};
                  run_gemm(lds, HBB, (const bf16_t*)(ws + WS_WGLAIN) + (size_t)i * GLA_N * DM, TH, 6144, DM, E); }
                GSYNC();
                gla_prep(lds, R0, R1, HSS, PTR(const float, 4) + i * 16 * 1024, PTR(const float, 5) + i * 1024, GBUF, HBA, RSA, vcu, G, wv);
                GSYNC();
                gla_scan(lds, R0, GBUF, HBA, RSA, R2, R2, HSS, vcu, G, wv);
                GSYNC();
                gla_norm_gate(R2, R3, HSS, PTR(const float, 6) + i * 512, tid);
                convert_p(PTR(const float, 1) + ((size_t)i * NB * SEQ + tok0) * PLE, PBF, tid);
                GSYNC();
                { EpiResid<false> E{i == 0 ? PTR(const float, 0) + tok0 * DM : (const float*)H, H, HBA, RSA, nullptr};
                  run_gemm(lds, R2, (const bf16_t*)(ws + WS_WGLAOUT) + (size_t)i * DM * MIX, TH, DM, MIX, E); }
                GSYNC();
            } else {
                const int jl = i - 2;
                if (jl == 0) {
                    { EpiProj2<0> E{RSB, R0, R0, 8, 1.f};
                      run_gemm(lds, HBB, (const bf16_t*)(ws + WS_WKV), TH, MIX, DM, E); }
                    { EpiVT E{RSB, R2};
                      run_gemm(lds, (const bf16_t*)(ws + WS_WKV) + (size_t)MIX * DM, HBB, MIX, TH, DM, E); }
                }
                convert_p(PTR(const float, 1) + ((size_t)i * NB * SEQ + tok0) * PLE, PBF, tid);
                { EpiProj2<1> E{RSB, R3, R4, 8, 0.08838834764831845f * 1.4426950408889634f};
                  run_gemm(lds, HBB, (const bf16_t*)(ws + WS_WDIN) + (size_t)jl * 4096 * DM, TH, 4096, DM, E); }
                GSYNC();
                const float lambda_init = 0.8f - 0.6f * expf(-0.3f * (float)i);
                attn_phase(lds, R3, R3, R0, R2, R4, PTR(const float, 11) + jl * 512, PTR(const float, 12) + jl * 256, lambda_init, vcu, G, wv);
                GSYNC();
                { EpiResid<false> E{H, H, HBA, RSA, nullptr};
                  run_gemm(lds, R3, (const bf16_t*)(ws + WS_WDOUT) + (size_t)jl * DM * MIX, TH, DM, MIX, E); }
                GSYNC();
            }
            { EpiGate E{RSA, GBUF};
              run_gemm(lds, HBA, (const bf16_t*)(ws + WS_WPG) + (size_t)i * DM * DM, TH, DM, DM, E); }
            { EpiResid<true> E{H, H, HBB, RSB, GBUF};
              run_gemm(lds, PBF, (const bf16_t*)(ws + WS_WPP) + (size_t)i * DM * PLE, TH, DM, PLE, E); }
            GSYNC();
        }
        final_rows(H, PTR(const float, 17), tid);
    }
}

#undef tid
#undef GSYNC
#undef run_gemm
#undef ws
#undef H
#undef HBB
#undef HBA
#undef RSB
#undef RSA
#undef PBF
#undef GBUF
#undef HSS
#undef R0
#undef R1
#undef R2
#undef R3
#undef R4
#undef PTR
#undef WSP
extern "C" void kernel_launch(void* const* d_in, const int* in_sizes, int n_in, void* d_out, int out_size, void* d_ws, size_t ws_size, hipStream_t stream) {
    static int grid = 0;
    if (grid == 0) {
        if (n_in != 18 || ws_size < WS_END) { fprintf(stderr, "kernel_launch: unexpected inputs (n_in %d, ws %zu)\n", n_in, ws_size); grid = -1; return; }
        int dev = 0, cus = 0, per_cu = 0;
        hipGetDevice(&dev);
        hipDeviceGetAttribute(&cus, hipDeviceAttributeMultiprocessorCount, dev);
        if (hipFuncSetAttribute((const void*)yoco_fwd, hipFuncAttributeMaxDynamicSharedMemorySize, LDS_BYTES) != hipSuccess) { fprintf(stderr, "hipFuncSetAttribute failed\n"); grid = -1; return; }
        if (hipOccupancyMaxActiveBlocksPerMultiprocessor(&per_cu, (const void*)yoco_fwd, 512, LDS_BYTES) != hipSuccess || per_cu < 1) per_cu = 1;
        (void)hipGetLastError();
        grid = cus * per_cu;
    }
    if (grid < 0) return;
    if (hipMemsetAsync(d_ws, 0, 65536, stream) != hipSuccess) { fprintf(stderr, "memset of barrier words failed\n"); return; }
    Params p{};
    p.x = (const float*)d_in[0]; p.p = (const float*)d_in[1]; p.norm_mix = (const float*)d_in[2]; p.gla_w_in = (const float*)d_in[3]; p.gla_w_gk2 = (const float*)d_in[4];
    p.gla_b_gk = (const float*)d_in[5]; p.gla_norm = (const float*)d_in[6]; p.gla_w_out = (const float*)d_in[7]; p.kv_norm = (const float*)d_in[8]; p.w_kv = (const float*)d_in[9];
    p.diff_w_in = (const float*)d_in[10]; p.diff_lambda = (const float*)d_in[11]; p.diff_norm = (const float*)d_in[12]; p.diff_w_out = (const float*)d_in[13];
    p.ple_norm = (const float*)d_in[14]; p.ple_w_gate = (const float*)d_in[15]; p.ple_w_proj = (const float*)d_in[16]; p.final_norm = (const float*)d_in[17];
    p.out = (float*)d_out; p.ws = (unsigned char*)d_ws;
    void* args[] = {&p};
    hipError_t e = hipLaunchCooperativeKernel((const void*)yoco_fwd, dim3(grid), dim3(512), args, LDS_BYTES, stream);
    if (e != hipSuccess) fprintf(stderr, "cooperative launch failed: %s (grid %d)\n", hipGetErrorString(e), grid);
}
```
